# Optimizing an MI355X kernel written in HIP

```python
import functools
import jax, jax.numpy as jnp
from jax import lax
import numpy as np

D_MODEL = 2048
BATCH = 4
SEQ = 2048
DEPTH = 4
DEC_BATCH = 32
DEC_SEQ = 8
PAST_LEN = 16384
PAGE_SIZE = 128

EXPAND = 2
E_WIDTH = EXPAND * D_MODEL
N_A = DEPTH // 2
N_B = DEPTH - N_A
DK_A = 128
H_A = D_MODEL // DK_A
DV_A = E_WIDTH // H_A
HD_B = 64
H_B = E_WIDTH // HD_B
KV_B = H_B // 8
G_B = H_B // KV_B
WINDOW = 128
N_META = 16
CHUNK = 16
EPS = 1e-6
NEG_BIG = -1e30
TINY = 1e-30

kernel_name = 'yoco_hgrn2_swa_sink_alibi_step'


def rmsnorm(x, g):
    x32 = x.astype(jnp.float32)
    y = x32 * lax.rsqrt(jnp.mean(x32 * x32, axis=-1, keepdims=True) + EPS)
    return (y * g.astype(jnp.float32)).astype(x.dtype)


def lower_bounds(lb_param):
    p = jax.nn.softmax(lb_param.astype(jnp.float32), axis=0)
    return jnp.cumsum(p, axis=0) - p[0]


def gla_chunk_scan(q, k, v, logf, s0):
    bsz, t_ = q.shape[:2]
    pad = (-t_) % CHUNK
    padw = ((0, 0), (0, pad), (0, 0), (0, 0))
    q, k, v, logf = [jnp.pad(a, padw) for a in (q, k, v, logf)]
    nc = (t_ + pad) // CHUNK

    def to_chunks(a):
        return jnp.moveaxis(a.reshape(bsz, nc, CHUNK, a.shape[2], a.shape[3]), 1, 0)

    causal = jnp.tril(jnp.ones((CHUNK, CHUNK), bool))[None, :, :, None, None]

    def step(S, inp):
        qc, kc, vc, gc = inp
        cum = jnp.cumsum(gc, axis=1)
        o_inter = jnp.einsum('bthd,bhde->bthe', qc * jnp.exp(cum), S)
        rel = cum[:, :, None] - cum[:, None, :]
        decay = jnp.where(causal, jnp.exp(jnp.where(causal, rel, 0.0)), 0.0)
        att = jnp.einsum('bthd,bshd,btshd->bhts', qc, kc, decay)
        o_intra = jnp.einsum('bhts,bshe->bthe', att, vc)
        last = cum[:, -1]
        S_new = jnp.exp(last)[..., None] * S + jnp.einsum(
            'bshd,bshe->bhde', kc * jnp.exp(last[:, None] - cum), vc)
        return S_new, o_inter + o_intra

    s_fin, o = lax.scan(step, s0, (to_chunks(q), to_chunks(k), to_chunks(v), to_chunks(logf)))
    o = jnp.moveaxis(o, 0, 1).reshape(bsz, nc * CHUNK, o.shape[-2], o.shape[-1])[:, :t_]
    return o, s_fin


def hgrn2_layer(x, s0, norm_g, w_in, lb, onorm_g, w_out):
    bsz, t_, _ = x.shape
    fd = H_A * DK_A
    z = rmsnorm(x, norm_g) @ w_in
    q, f, i, g = jnp.split(z, [fd, 2 * fd, 2 * fd + E_WIDTH], axis=-1)
    f = f.astype(jnp.float32)
    q = jax.nn.silu(q.astype(jnp.float32)) * (DK_A ** -0.5)
    base = jnp.log1p(-lb) + jax.nn.log_sigmoid(f)
    logf = jnp.where(lb > 0, jnp.logaddexp(jnp.log(jnp.maximum(lb, TINY)), base), base)
    k = (1.0 - lb) * jax.nn.sigmoid(-f)
    o, s_fin = gla_chunk_scan(q.reshape(bsz, t_, H_A, DK_A), k.reshape(bsz, t_, H_A, DK_A),
                              i.astype(jnp.float32).reshape(bsz, t_, H_A, DV_A),
                              logf.reshape(bsz, t_, H_A, DK_A), s0)
    o = rmsnorm(o, onorm_g).reshape(bsz, t_, E_WIDTH) * jax.nn.silu(g.astype(jnp.float32))
    return x + o.astype(x.dtype) @ w_out, s_fin


def alibi_slopes():
    h = jnp.arange(1, H_B + 1, dtype=jnp.float32)
    return (2.0 ** (-8.0 * h / H_B)).reshape(KV_B, G_B, 1, 1)


def sink_softmax_attention(q, k, v, dist, valid, sink):
    s = jnp.einsum('...ikgd,...jkd->...kgij', q.astype(jnp.float32), k.astype(jnp.float32)) * (HD_B ** -0.5)
    s = s - alibi_slopes() * dist.astype(jnp.float32)
    s = jnp.where(valid, s, NEG_BIG)
    m = jnp.maximum(jnp.max(s, axis=-1, keepdims=True), sink)
    p = jnp.where(valid, jnp.exp(s - m), 0.0)
    denom = jnp.sum(p, axis=-1, keepdims=True) + jnp.exp(sink - m)
    return jnp.einsum('...kgij,...jkd->...ikgd', p / denom, v.astype(jnp.float32))


def banded_attend(q, k, v, sink):
    bsz, t_ = q.shape[:2]
    nb = -(-t_ // WINDOW)
    pad = nb * WINDOW - t_
    qb = jnp.pad(q, ((0, 0), (0, pad), (0, 0), (0, 0), (0, 0))).reshape(bsz, nb, WINDOW, KV_B, G_B, HD_B)

    def band(a):
        a = jnp.pad(a, ((0, 0), (0, pad), (0, 0), (0, 0))).reshape(bsz, nb, WINDOW, KV_B, HD_B)
        prev = jnp.pad(a, ((0, 0), (1, 0), (0, 0), (0, 0), (0, 0)))[:, :-1]
        return jnp.concatenate([prev, a], axis=2)

    i = jnp.arange(WINDOW)[:, None]
    j = jnp.arange(2 * WINDOW)[None, :]
    dist = WINDOW + i - j
    valid = (dist >= 0) & (dist < WINDOW)
    valid = valid[None] & ((jnp.arange(nb)[:, None, None] > 0) | (j >= WINDOW)[None])
    o = sink_softmax_attention(qb, band(k), band(v), dist, valid[:, None, None], sink)
    return o.reshape(bsz, nb * WINDOW, KV_B, G_B, HD_B)[:, :t_]


def cached_attend(q, k, v, sink, past_k, past_v):
    wb = past_k.shape[1]
    t_ = q.shape[1]
    kf = jnp.concatenate([past_k.astype(k.dtype), k], axis=1)
    vf = jnp.concatenate([past_v.astype(v.dtype), v], axis=1)
    i = jnp.arange(t_)[:, None]
    j = jnp.arange(wb + t_)[None, :]
    dist = wb + i - j
    valid = (dist >= 0) & (dist < WINDOW)
    return sink_softmax_attention(q, kf, vf, dist, valid, sink)


def swa_layer(x, k_sh, v_sh, attend, norm_g, w_in, sink, w_out):
    bsz, t_, _ = x.shape
    z = rmsnorm(x, norm_g) @ w_in
    q, gate = jnp.split(z, 2, axis=-1)
    q = q.reshape(bsz, t_, KV_B, G_B, HD_B)
    o = attend(q, k_sh, v_sh, sink.astype(jnp.float32).reshape(KV_B, G_B, 1, 1))
    o = o.reshape(bsz, t_, E_WIDTH) * jax.nn.silu(gate.astype(jnp.float32))
    return x + o.astype(x.dtype) @ w_out


def trunk(x, s0, attend, norm_a, w_in_a, lb_a, onorm_a, w_out_a, norm_kv, w_kv,
          norm_b, w_in_b, sink_b, w_out_b, norm_f):
    bsz, t_, _ = x.shape
    lbs = lower_bounds(lb_a)
    states = []
    k_sh = v_sh = None
    for layer in range(DEPTH):
        if layer < N_A:
            x, s = hgrn2_layer(x, s0[layer], norm_a[layer], w_in_a[layer], lbs[layer],
                               onorm_a[layer], w_out_a[layer])
            states.append(s)
            if layer == N_A - 1:
                kv = rmsnorm(x, norm_kv) @ w_kv
                k_sh, v_sh = jnp.split(kv, 2, axis=-1)
                k_sh = k_sh.reshape(bsz, t_, KV_B, HD_B)
                v_sh = v_sh.reshape(bsz, t_, KV_B, HD_B)
        else:
            lb_i = layer - N_A
            x = swa_layer(x, k_sh, v_sh, attend, norm_b[lb_i], w_in_b[lb_i], sink_b[lb_i], w_out_b[lb_i])
    return rmsnorm(x, norm_f), jnp.stack(states), k_sh, v_sh


def setup_inputs(seed: int = 0) -> dict:
    key = jax.random.key(seed)
    ks = jax.random.split(key, 20)
    f32 = jnp.float32
    wb = min(WINDOW, PAST_LEN)
    za = 2 * H_A * DK_A + 2 * E_WIDTH

    def nrm(k, shape, s):
        return s * jax.random.normal(k, shape, f32)

    return {
        'x_prompt': nrm(ks[0], (BATCH, SEQ, D_MODEL), 1.0),
        'x_sample': nrm(ks[1], (DEC_BATCH, DEC_SEQ, D_MODEL), 1.0),
        'state_hgrn': nrm(ks[2], (N_A, DEC_BATCH, H_A, DK_A, DV_A), 0.3),
        'cache_k': nrm(ks[3], (DEC_BATCH, wb, KV_B, HD_B), 1.0),
        'cache_v': nrm(ks[4], (DEC_BATCH, wb, KV_B, HD_B), 1.0),
        'meta_tokens': nrm(ks[5], (N_META, D_MODEL), 1.0),
        'norm_a': 1.0 + nrm(ks[6], (N_A, D_MODEL), 0.02),
        'w_in_a': nrm(ks[7], (N_A, D_MODEL, za), D_MODEL ** -0.5),
        'lb_a': nrm(ks[8], (N_A, H_A * DK_A), 0.5),
        'onorm_a': 1.0 + nrm(ks[9], (N_A, DV_A), 0.02),
        'w_out_a': nrm(ks[10], (N_A, E_WIDTH, D_MODEL), E_WIDTH ** -0.5),
        'norm_kv': 1.0 + nrm(ks[11], (D_MODEL,), 0.02),
        'w_kv': nrm(ks[12], (D_MODEL, 2 * KV_B * HD_B), D_MODEL ** -0.5),
        'norm_b': 1.0 + nrm(ks[13], (N_B, D_MODEL), 0.02),
        'w_in_b': nrm(ks[14], (N_B, D_MODEL, 2 * E_WIDTH), D_MODEL ** -0.5),
        'sink_b': nrm(ks[15], (N_B, H_B), 0.5),
        'w_out_b': nrm(ks[16], (N_B, E_WIDTH, D_MODEL), E_WIDTH ** -0.5),
        'norm_f': 1.0 + nrm(ks[17], (D_MODEL,), 0.02),
    }


def reference(x_prompt, x_sample, state_hgrn, cache_k, cache_v, meta_tokens, norm_a, w_in_a, lb_a,
              onorm_a, w_out_a, norm_kv, w_kv, norm_b, w_in_b, sink_b, w_out_b, norm_f):
    weights = (norm_a, w_in_a, lb_a, onorm_a, w_out_a, norm_kv, w_kv, norm_b, w_in_b, sink_b, w_out_b, norm_f)
    bsz = x_prompt.shape[0]
    wb = cache_k.shape[1]
    meta = jnp.broadcast_to(meta_tokens.astype(x_prompt.dtype)[None], (bsz, N_META, D_MODEL))
    xp = jnp.concatenate([meta, x_prompt], axis=1)
    s0p = jnp.zeros((N_A, bsz, H_A, DK_A, DV_A), jnp.float32)
    yp, sp, kp, vp = trunk(xp, s0p, banded_attend, *weights)
    attend_s = functools.partial(cached_attend, past_k=cache_k, past_v=cache_v)
    ys, ss, k_new, v_new = trunk(x_sample, state_hgrn.astype(jnp.float32), attend_s, *weights)
    y_prompt = yp[:, N_META:]
    state_hgrn_prompt = sp.astype(state_hgrn.dtype)
    cache_k_prompt = kp[:, -wb:].astype(cache_k.dtype)
    cache_v_prompt = vp[:, -wb:].astype(cache_v.dtype)
    state_hgrn_sample = ss.astype(state_hgrn.dtype)
    cache_k_sample = jnp.concatenate([cache_k, k_new.astype(cache_k.dtype)], axis=1)[:, -wb:]
    cache_v_sample = jnp.concatenate([cache_v, v_new.astype(cache_v.dtype)], axis=1)[:, -wb:]
    return (y_prompt, ys, state_hgrn_prompt, cache_k_prompt, cache_v_prompt,
            state_hgrn_sample, cache_k_sample, cache_v_sample)
```

```cpp
#include <hip/hip_runtime.h>
#include <hip/hip_cooperative_groups.h>
#include <cstdio>
#include <cstdint>
namespace cg = cooperative_groups;

#define LAS __attribute__((address_space(3)))
#define DI __device__ __forceinline__
typedef unsigned short bf16_t;
typedef short bf16x8 __attribute__((ext_vector_type(8)));
typedef float f32x4 __attribute__((ext_vector_type(4)));
typedef float f32x2 __attribute__((ext_vector_type(2)));
typedef unsigned u32x4 __attribute__((ext_vector_type(4)));
typedef unsigned u32x2 __attribute__((ext_vector_type(2)));
typedef __bf16 bf2_t __attribute__((ext_vector_type(2)));

constexpr int D = 2048, EW = 4096, TP = 2064, NPR = 8256, MT = 8512, MP = 8704;
constexpr float EPS = 1e-6f;
constexpr size_t O_YP = 0, O_YS = 16777216, O_SP = 17301504, O_CKP = 21495808, O_CVP = 21757952, O_SS = 22020096, O_CKS = 55574528, O_CVS = 57671680;
constexpr size_t OFF_WIN_A = 0, OFF_WOUT_A = 100663296, OFF_WKV = 134217728, OFF_WIN_B = 138412032, OFF_WOUT_B = 205520896,
                 OFF_X = 239075328, OFF_XB = 310378496, OFF_Q = 346030080, OFF_K = 381681664, OFF_LF = 417333248, OFF_VT = 488636416,
                 OFF_G = 559939584, OFF_OG = 631242752, OFF_KS = 702545920, OFF_VTS = 711458816, OFF_LB = 720371712, OFF_CTL = 720388096, CTL_BYTES = 16384, OFF_SS = 720404480, WS_END = 720404480 + 5 * 8704 * 4;
constexpr int LDS_BYTES = 155712, LDS_ST = 155648;

struct Params { const float* in[18]; float* out; unsigned char* ws; };

DI unsigned pk2(float a, float b) { f32x2 v = {a, b}; bf2_t r = __builtin_convertvector(v, bf2_t); return __builtin_bit_cast(unsigned, r); }
DI float bflo(unsigned u) { return __uint_as_float(u << 16); }
DI float bfhi(unsigned u) { return __uint_as_float(u & 0xffff0000u); }
DI float bf2f(bf16_t h) { return __uint_as_float((unsigned)h << 16); }
DI float fsilu(float v) { return v * __builtin_amdgcn_rcpf(1.f + __expf(-v)); }
DI void lds_barrier() { asm volatile("s_waitcnt lgkmcnt(0)" ::: "memory"); __builtin_amdgcn_s_barrier(); asm volatile("" ::: "memory"); }
DI float wave_sum(float v) {
#pragma unroll
    for (int o = 1; o < 64; o <<= 1) v += __shfl_xor(v, o);
    return v;
}

constexpr int BM = 256, BK = 64, HALF = 128, HTB = HALF * BK * 2;
DI int lds_byte(int r, int c) { const int st = (r >> 4) * 2 + (c >> 5), rr = r & 15, cc = c & 31, ob = rr * 64 + cc * 2; return st * 1024 + (ob ^ (((ob >> 9) & 1) << 5)); }
DI void stage_rc(int b, int& R, int& C) { const int st = b / 1024, sb = b % 1024, swz = sb ^ (((sb >> 9) & 1) << 5); R = (st >> 1) * 16 + swz / 64; C = (st & 1) * 32 + (swz % 64) / 2; }
DI int perm32(int rho) { const int n = rho >> 4, i = rho & 15; return 8 * (i >> 2) + 4 * n + (i & 3); }

struct GUnit { const char* a; const char* b; int pm, pn, nt, piece; };
struct GSched {
    const char* X; const char* W; int K, nM, nN, pn0, t0, t1, G, c, split;
    DI bool next(int i, GUnit& u) const {
        const long L = (long)i * G + c; const int nMf = split ? 32 : nM; const int nwg = nMf * nN;
        const size_t tstep = (size_t)BM * K * 2;
        if (L >= nwg) {
            if (!split) return false;
            const int idx = (int)(L - nwg); if (idx >= 256) return false;
            const int uu = idx >> 4, kp = idx & 15;
            u.pm = 32 + (uu >> 3); u.pn = uu & 7; u.nt = 4; u.piece = idx;
            u.a = X + (size_t)u.pm * tstep + (size_t)kp * 512; u.b = W + (size_t)u.pn * tstep + (size_t)kp * 512;
            return true;
        }
        int wgid = (int)L; { const int q = nwg / 8, r = nwg % 8, xcd = wgid % 8, off = wgid / 8; wgid = (xcd < r ? xcd * (q + 1) : r * (q + 1) + (xcd - r) * q) + off; }
        const int nig = 8 * nN, gid = wgid / nig, fm = gid * 8, gsz = (nMf - fm) < 8 ? (nMf - fm) : 8;
        u.pm = fm + ((wgid % nig) % gsz); u.pn = pn0 + (wgid % nig) / gsz; u.nt = K / BK; u.piece = -1;
        const char* xp = X + (size_t)u.pm * tstep; const char* wp = W + (size_t)u.pn * tstep;
        const bool tr = (u.pn >= t0) && (u.pn < t1);
        u.a = tr ? wp : xp; u.b = tr ? xp : wp;
        return true;
    }
};

template <class Epi>
DI void gemm_phase(LAS unsigned char* lds, const GSched& S, const Epi& E) {
    int tid = threadIdx.x; asm volatile("" : "+v"(tid));
    const int wid = __builtin_amdgcn_readfirstlane(tid >> 6), lane = tid & 63, wr = wid >> 2, wc = wid & 3, fr = lane & 15, fq = lane >> 4;
    const int K = S.K;
    unsigned voffA[2], voffB[2];
#pragma unroll
    for (int i = 0; i < 2; ++i) { int R, C; stage_rc(tid * 16 + i * 8192, R, C); const int Rb = (R & ~31) + perm32(R & 31);
        voffA[i] = (unsigned)(R * K + C) * 2u; voffB[i] = (unsigned)(Rb * K + C) * 2u; }
    const size_t kstep = (size_t)(BK * 2);
    const size_t hstep = (size_t)HALF * K * 2;
    const unsigned ldsw = (unsigned)wid * 1024u;
    const int aoff = lds_byte(wr * 64 + fr, fq * 8), boff = lds_byte(wc * 32 + fr, fq * 8);
#define PG8_SA(b, h) (((b) * 2 + (h)) * HTB)
#define PG8_SB(b, h) ((4 + (b) * 2 + (h)) * HTB)
#define PG8_STAGE(bufoff, gbase, voff) do { _Pragma("unroll") for (int _i = 0; _i < 2; ++_i) \
        __builtin_amdgcn_global_load_lds((const unsigned*)((const char*)(gbase) + (voff)[_i]), (LAS unsigned*)(lds + (bufoff) + ldsw + _i * 8192), 16, 0, 0); } while (0)
#define PG8_LDA(dst, b, h) do { _Pragma("unroll") for (int m = 0; m < 4; ++m) _Pragma("unroll") for (int k = 0; k < 2; ++k) dst[m][k] = *(const LAS bf16x8*)(lds + PG8_SA(b, h) + aoff + m * 2048 + k * 1024); } while (0)
#define PG8_LDB(dst, b, h) do { _Pragma("unroll") for (int n = 0; n < 2; ++n) _Pragma("unroll") for (int k = 0; k < 2; ++k) dst[n][k] = *(const LAS bf16x8*)(lds + PG8_SB(b, h) + boff + n * 2048 + k * 1024); } while (0)
#define PG8_MMA(ai, bj, At, Bt) do { __builtin_amdgcn_s_setprio(1); _Pragma("unroll") for (int m = 0; m < 4; ++m) _Pragma("unroll") for (int n = 0; n < 2; ++n) _Pragma("unroll") for (int k = 0; k < 2; ++k) \
        acc[ai][bj][m][n] = __builtin_amdgcn_mfma_f32_16x16x32_bf16(Bt[n][k], At[m][k], acc[ai][bj][m][n], 0, 0, 0); __builtin_amdgcn_s_setprio(0); } while (0)
#define PG8_WAIT_V(n) asm volatile("s_waitcnt vmcnt(" #n ")" ::: "memory")
#define PG8_WAIT_L(n) asm volatile("s_waitcnt lgkmcnt(" #n ")" ::: "memory")
#define PG8_BAR __builtin_amdgcn_s_barrier()
#define PG8_SCHED __builtin_amdgcn_sched_barrier(0)
    GUnit cur, nxt; int ui = 0;
    if (!S.next(0, cur)) return;
    f32x4 acc[2][2][4][2];
#pragma unroll
    for (int a = 0; a < 2; ++a)
#pragma unroll
        for (int b = 0; b < 2; ++b)
#pragma unroll
            for (int m = 0; m < 4; ++m)
#pragma unroll
                for (int n = 0; n < 2; ++n) acc[a][b][m][n] = (f32x4){0.f, 0.f, 0.f, 0.f};
    bf16x8 At[4][2], B0[2][2], B1[2][2];
    const char* cA = cur.a; const char* cB = cur.b;
    PG8_STAGE(PG8_SB(0, 0), cB, voffB); PG8_STAGE(PG8_SB(0, 1), cB + hstep, voffB); PG8_STAGE(PG8_SA(0, 0), cA, voffA); PG8_STAGE(PG8_SA(0, 1), cA + hstep, voffA);
    if (wr == 1) PG8_BAR;
    PG8_WAIT_V(2); PG8_BAR;
    PG8_STAGE(PG8_SB(1, 0), cB + kstep, voffB); PG8_STAGE(PG8_SA(1, 0), cA + kstep, voffA); PG8_STAGE(PG8_SB(1, 1), cB + hstep + kstep, voffB);
    PG8_WAIT_V(6); PG8_BAR;
    for (;;) {
        const bool has_next = S.next(ui + 1, nxt);
        const char* nA = has_next ? nxt.a : cA; const char* nB = has_next ? nxt.b : cB;
        const int nt = cur.nt;
        for (int t = 0; t < nt; t += 2) {
            const bool last = (t == nt - 2);
            const char* a1 = cA + (size_t)(t + 1) * kstep;
            const char* a2 = last ? nA : cA + (size_t)(t + 2) * kstep; const char* b2 = last ? nB : cB + (size_t)(t + 2) * kstep;
            const char* a3 = a2 + kstep; const char* b3 = b2 + kstep;
            PG8_LDB(B0, 0, 0); PG8_LDB(B1, 0, 1); PG8_SCHED; PG8_LDA(At, 0, 0); PG8_STAGE(PG8_SA(1, 1), a1 + hstep, voffA);
            PG8_WAIT_V(8); PG8_WAIT_L(0); PG8_BAR; PG8_MMA(0, 0, At, B0); PG8_MMA(0, 1, At, B1); PG8_BAR; PG8_SCHED;
            PG8_LDA(At, 0, 1); PG8_STAGE(PG8_SB(0, 0), b2, voffB); PG8_STAGE(PG8_SB(0, 1), b2 + hstep, voffB); PG8_STAGE(PG8_SA(0, 0), a2, voffA);
            PG8_WAIT_V(8); PG8_WAIT_L(0); PG8_BAR; PG8_MMA(1, 0, At, B0); PG8_MMA(1, 1, At, B1); PG8_BAR; PG8_SCHED;
            PG8_LDB(B0, 1, 0); PG8_LDB(B1, 1, 1); PG8_SCHED; PG8_LDA(At, 1, 0); PG8_STAGE(PG8_SA(0, 1), a2 + hstep, voffA);
            PG8_WAIT_V(8); PG8_WAIT_L(0); PG8_BAR; PG8_MMA(0, 0, At, B0); PG8_MMA(0, 1, At, B1); PG8_BAR; PG8_SCHED;
            PG8_LDA(At, 1, 1); PG8_STAGE(PG8_SB(1, 0), b3, voffB); PG8_STAGE(PG8_SB(1, 1), b3 + hstep, voffB); PG8_STAGE(PG8_SA(1, 0), a3, voffA);
            PG8_WAIT_V(8); PG8_WAIT_L(0); PG8_BAR; PG8_MMA(1, 0, At, B0); PG8_MMA(1, 1, At, B1); PG8_BAR; PG8_SCHED;
        }
        if (wr == 0) PG8_BAR;
        E(acc, cur, wr, wc, fr, fq);
        if (!has_next) break;
#pragma unroll
        for (int a = 0; a < 2; ++a)
#pragma unroll
            for (int b = 0; b < 2; ++b)
#pragma unroll
                for (int m = 0; m < 4; ++m)
#pragma unroll
                    for (int n = 0; n < 2; ++n) acc[a][b][m][n] = (f32x4){0.f, 0.f, 0.f, 0.f};
        cur = nxt; cA = nA; cB = nB; ++ui;
        if (wr == 1) PG8_BAR;
    }
    PG8_WAIT_V(0);
    PG8_BAR;
#undef PG8_SA
#undef PG8_SB
#undef PG8_STAGE
#undef PG8_LDA
#undef PG8_LDB
#undef PG8_MMA
#undef PG8_WAIT_V
#undef PG8_WAIT_L
#undef PG8_BAR
#undef PG8_SCHED
}

struct EpiHgrnIn {
    bf16_t* Qb; bf16_t* Kb; float* LF; bf16_t* VT; bf16_t* Gb; const float* lb; const float* SS; const float* onorm;
    DI void operator()(const f32x4 (&acc_in)[2][2][4][2], const GUnit& u, int wr, int wc, int fr, int fq) const {
        const int pn = u.pn;
        if (pn >= 32) {
            const int f0 = (pn - 32) * 256 + wr * 64 + fr, t0 = u.pm * 256 + wc * 32 + 8 * fq;
            f32x4 rt[2][2];
#pragma unroll
            for (int bj = 0; bj < 2; ++bj)
#pragma unroll
                for (int n = 0; n < 2; ++n) { const f32x4 s = *(const f32x4*)(SS + t0 + bj * 128 + 4 * n);
                    rt[bj][n] = (f32x4){__builtin_amdgcn_rsqf(s[0] * (1.f / D) + EPS), __builtin_amdgcn_rsqf(s[1] * (1.f / D) + EPS), __builtin_amdgcn_rsqf(s[2] * (1.f / D) + EPS), __builtin_amdgcn_rsqf(s[3] * (1.f / D) + EPS)}; }
#pragma unroll
            for (int ai = 0; ai < 2; ++ai)
#pragma unroll
                for (int m = 0; m < 4; ++m) { bf16_t* rowp = VT + (size_t)(f0 + ai * 128 + m * 16) * MP + t0;
#pragma unroll
                    for (int bj = 0; bj < 2; ++bj) { const f32x4 v0 = acc_in[ai][bj][m][0] * rt[bj][0], v1 = acc_in[ai][bj][m][1] * rt[bj][1];
                        u32x4 w = {pk2(v0[0], v0[1]), pk2(v0[2], v0[3]), pk2(v1[0], v1[1]), pk2(v1[2], v1[3])}; *(u32x4*)(rowp + bj * 128) = w; } }
            return;
        }
        const int row0 = u.pm * 256 + wr * 64 + fr;
        if (pn < 8) {
            const int col0 = pn * 256 + wc * 32 + 8 * fq; const float QS = 0.08838834764831845f;
#pragma unroll
            for (int ai = 0; ai < 2; ++ai)
#pragma unroll
                for (int m = 0; m < 4; ++m) { bf16_t* rowp = Qb + (size_t)(row0 + ai * 128 + m * 16) * D + col0;
                    const float rs = __builtin_amdgcn_rsqf(SS[row0 + ai * 128 + m * 16] * (1.f / D) + EPS);
#pragma unroll
                    for (int bj = 0; bj < 2; ++bj) { const f32x4 v0 = acc_in[ai][bj][m][0] * rs, v1 = acc_in[ai][bj][m][1] * rs;
                        u32x4 w = {pk2(fsilu(v0[0]) * QS, fsilu(v0[1]) * QS), pk2(fsilu(v0[2]) * QS, fsilu(v0[3]) * QS), pk2(fsilu(v1[0]) * QS, fsilu(v1[1]) * QS), pk2(fsilu(v1[2]) * QS, fsilu(v1[3]) * QS)};
                        *(u32x4*)(rowp + bj * 128) = w; } }
        } else if (pn < 16) {
            const int col0 = (pn - 8) * 256 + wc * 32 + 8 * fq;
#pragma unroll
            for (int bj = 0; bj < 2; ++bj) {
                const f32x4 l0 = *(const f32x4*)(lb + col0 + bj * 128), l1 = *(const f32x4*)(lb + col0 + bj * 128 + 4);
#pragma unroll
                for (int ai = 0; ai < 2; ++ai)
#pragma unroll
                    for (int m = 0; m < 4; ++m) { const size_t ro = (size_t)(row0 + ai * 128 + m * 16) * D + col0 + bj * 128;
                        const float rs = __builtin_amdgcn_rsqf(SS[row0 + ai * 128 + m * 16] * (1.f / D) + EPS);
                        f32x4 lf0, lf1; float kk[8];
#pragma unroll
                        for (int e = 0; e < 8; ++e) { float f = (e < 4 ? acc_in[ai][bj][m][0][e & 3] : acc_in[ai][bj][m][1][e & 3]) * rs; const float lbv = e < 4 ? l0[e & 3] : l1[e & 3];
                            f = fminf(fmaxf(f, -80.f), 80.f);
                            const float ex = __expf(-f), sig = __builtin_amdgcn_rcpf(1.f + ex), om = 1.f - lbv;
                            const float lg = __log2f(lbv + om * sig); kk[e] = om * ex * sig;
                            if (e < 4) lf0[e & 3] = lg; else lf1[e & 3] = lg; }
                        *(f32x4*)(LF + ro) = lf0; *(f32x4*)(LF + ro + 4) = lf1;
                        u32x4 w = {pk2(kk[0], kk[1]), pk2(kk[2], kk[3]), pk2(kk[4], kk[5]), pk2(kk[6], kk[7])}; *(u32x4*)(Kb + ro) = w; }
            }
        } else {
            const int col0 = (pn - 16) * 256 + wc * 32 + 8 * fq;
            f32x4 on[2][2];
#pragma unroll
            for (int bj = 0; bj < 2; ++bj) { on[bj][0] = *(const f32x4*)(onorm + wc * 32 + 8 * fq + bj * 128); on[bj][1] = *(const f32x4*)(onorm + wc * 32 + 8 * fq + bj * 128 + 4); }
#pragma unroll
            for (int ai = 0; ai < 2; ++ai)
#pragma unroll
                for (int m = 0; m < 4; ++m) { bf16_t* rowp = Gb + (size_t)(row0 + ai * 128 + m * 16) * EW + col0;
                    const float rs = __builtin_amdgcn_rsqf(SS[row0 + ai * 128 + m * 16] * (1.f / D) + EPS);
#pragma unroll
                    for (int bj = 0; bj < 2; ++bj) { const f32x4 v0 = acc_in[ai][bj][m][0] * rs, v1 = acc_in[ai][bj][m][1] * rs; const f32x4 n0 = on[bj][0], n1 = on[bj][1];
                        u32x4 w = {pk2(fsilu(v0[0]) * n0[0], fsilu(v0[1]) * n0[1]), pk2(fsilu(v0[2]) * n0[2], fsilu(v0[3]) * n0[3]), pk2(fsilu(v1[0]) * n1[0], fsilu(v1[1]) * n1[1]), pk2(fsilu(v1[2]) * n1[2], fsilu(v1[3]) * n1[3])};
                        *(u32x4*)(rowp + bj * 128) = w; } }
        }
    }
};

struct EpiOut {
    float* X; bf16_t* XB; float* SS; float* P;
    DI void operator()(const f32x4 (&acc)[2][2][4][2], const GUnit& u, int wr, int wc, int fr, int fq) const {
        if (u.piece >= 0) {
            float* pb = P + (size_t)u.piece * 65536 + (wr * 64 + fr) * 256 + wc * 32 + 8 * fq;
#pragma unroll
            for (int ai = 0; ai < 2; ++ai)
#pragma unroll
                for (int m = 0; m < 4; ++m)
#pragma unroll
                    for (int bj = 0; bj < 2; ++bj) { f32x4* q = (f32x4*)(pb + (ai * 128 + m * 16) * 256 + bj * 128); q[0] = acc[ai][bj][m][0]; q[1] = acc[ai][bj][m][1]; }
            return;
        }
        const int row0 = u.pm * 256 + wr * 64 + fr, col0 = u.pn * 256 + wc * 32 + 8 * fq;
#pragma unroll
        for (int ai = 0; ai < 2; ++ai)
#pragma unroll
            for (int m = 0; m < 4; ++m) { const int row = row0 + ai * 128 + m * 16; float* rowp = X + (size_t)row * D + col0; bf16_t* bp = XB + (size_t)row * D + col0; float ss = 0.f;
#pragma unroll
                for (int bj = 0; bj < 2; ++bj) { f32x4* p = (f32x4*)(rowp + bj * 128); const f32x4 x0 = p[0] + acc[ai][bj][m][0], x1 = p[1] + acc[ai][bj][m][1]; p[0] = x0; p[1] = x1;
                    u32x4 w = {pk2(x0[0], x0[1]), pk2(x0[2], x0[3]), pk2(x1[0], x1[1]), pk2(x1[2], x1[3])}; *(u32x4*)(bp + bj * 128) = w;
                    ss += (x0[0] * x0[0] + x0[1] * x0[1]) + (x0[2] * x0[2] + x0[3] * x0[3]) + (x1[0] * x1[0] + x1[1] * x1[1]) + (x1[2] * x1[2] + x1[3] * x1[3]); }
                ss += __shfl_xor(ss, 16); ss += __shfl_xor(ss, 32);
                if (fq == 0) __hip_atomic_fetch_add(SS + row, ss, __ATOMIC_RELAXED, __HIP_MEMORY_SCOPE_AGENT); }
    }
};

struct EpiSwaIn {
    bf16_t* KS; bf16_t* VTS; bf16_t* QA; bf16_t* GA; const float* SS;
    DI void operator()(const f32x4 (&acc)[2][2][4][2], const GUnit& u, int wr, int wc, int fr, int fq) const {
        const int pn = u.pn;
        const bool tr = (pn == 2 || pn == 3);
        bf16_t* base; int ld, r0, c0; int act;
        if (tr) { base = VTS; ld = MP; r0 = (pn - 2) * 256; c0 = u.pm * 256; act = 0; }
        else if (pn < 2) { base = KS; ld = 512; r0 = u.pm * 256; c0 = pn * 256; act = 0; }
        else if (pn < 20) { base = QA; ld = EW; r0 = u.pm * 256; c0 = (pn - 4) * 256; act = 1; }
        else { base = GA; ld = EW; r0 = u.pm * 256; c0 = (pn - 20) * 256; act = 2; }
        const int row0 = r0 + wr * 64 + fr, col0 = c0 + wc * 32 + 8 * fq;
        f32x4 rt[2][2];
#pragma unroll
        for (int bj = 0; bj < 2; ++bj)
#pragma unroll
            for (int n = 0; n < 2; ++n) { rt[bj][n] = (f32x4){1.f, 1.f, 1.f, 1.f};
                if (tr) { const f32x4 s = *(const f32x4*)(SS + col0 + bj * 128 + 4 * n);
                    rt[bj][n] = (f32x4){__builtin_amdgcn_rsqf(s[0] * (1.f / D) + EPS), __builtin_amdgcn_rsqf(s[1] * (1.f / D) + EPS), __builtin_amdgcn_rsqf(s[2] * (1.f / D) + EPS), __builtin_amdgcn_rsqf(s[3] * (1.f / D) + EPS)}; } }
#pragma unroll
        for (int ai = 0; ai < 2; ++ai)
#pragma unroll
            for (int m = 0; m < 4; ++m) { bf16_t* rowp = base + (size_t)(row0 + ai * 128 + m * 16) * ld + col0;
                const float rs = tr ? 1.f : __builtin_amdgcn_rsqf(SS[row0 + ai * 128 + m * 16] * (1.f / D) + EPS);
#pragma unroll
                for (int bj = 0; bj < 2; ++bj) { f32x4 v0 = acc[ai][bj][m][0] * rt[bj][0] * rs, v1 = acc[ai][bj][m][1] * rt[bj][1] * rs;
                    if (act == 1) { v0 = v0 * 0.18033688011112042f; v1 = v1 * 0.18033688011112042f; }
                    else if (act == 2) { v0 = (f32x4){fsilu(v0[0]), fsilu(v0[1]), fsilu(v0[2]), fsilu(v0[3])}; v1 = (f32x4){fsilu(v1[0]), fsilu(v1[1]), fsilu(v1[2]), fsilu(v1[3])}; }
                    u32x4 w = {pk2(v0[0], v0[1]), pk2(v0[2], v0[3]), pk2(v1[0], v1[1]), pk2(v1[2], v1[3])}; *(u32x4*)(rowp + bj * 128) = w; } }
    }
};

DI void tr_load(const float* W, int N, int nblk, int item, int lane, f32x4 (&v)[8]) {
    const int kb = item / nblk, nb = item - kb * nblk, k0 = 64 * kb, n0 = 32 * nb, lr = lane >> 3, lc = (lane & 7) * 4;
#pragma unroll
    for (int i = 0; i < 8; ++i) v[i] = __builtin_nontemporal_load((const f32x4*)(W + (size_t)(k0 + 8 * i + lr) * N + n0 + lc));
}
DI void tr_store(const f32x4 (&v)[8], int K, int nblk, const float* gain, bf16_t* WT, int mapkind, LAS float* scr, int item, int lane) {
    const int kb = item / nblk, nb = item - kb * nblk, k0 = 64 * kb, n0 = 32 * nb, lr = lane >> 3, lc = (lane & 7) * 4;
    int r0 = n0;
    if (mapkind == 1) r0 = n0 < 4096 ? n0 : (n0 < 8192 ? n0 + 4096 : n0 - 4096);
#pragma unroll
    for (int i = 0; i < 8; ++i) { const float gv = gain ? gain[k0 + 8 * i + lr] : 1.f; LAS float* d = scr + (8 * i + lr) * 33 + lc; d[0] = v[i].x * gv; d[1] = v[i].y * gv; d[2] = v[i].z * gv; d[3] = v[i].w * gv; }
    asm volatile("s_waitcnt lgkmcnt(0)" ::: "memory");
    const int c = lane & 7;
#pragma unroll
    for (int j = 0; j < 4; ++j) { const int n = (lane >> 3) + 8 * j; const LAS float* s = scr + (8 * c) * 33 + n;
        u32x4 o; o.x = pk2(s[0 * 33], s[1 * 33]); o.y = pk2(s[2 * 33], s[3 * 33]); o.z = pk2(s[4 * 33], s[5 * 33]); o.w = pk2(s[6 * 33], s[7 * 33]);
        *(u32x4*)(WT + (size_t)(r0 + n) * K + k0 + 8 * c) = o; }
    asm volatile("s_waitcnt lgkmcnt(0)" ::: "memory");
}
DI void convert_matrix(LAS unsigned char* lds, const Params& p, int id, int wslot, int nslots, int lane, int wave) {
    const float* W; const float* gain = nullptr; bf16_t* WT; int K, N, mapkind = 0;
    unsigned char* ws = p.ws;
    if (id < 2) { W = p.in[7] + (size_t)id * D * 12288; gain = p.in[6] + id * D; WT = (bf16_t*)(ws + OFF_WIN_A) + (size_t)id * 12288 * D; K = D; N = 12288; mapkind = 1; }
    else if (id < 4) { W = p.in[10] + (size_t)(id - 2) * EW * D; WT = (bf16_t*)(ws + OFF_WOUT_A) + (size_t)(id - 2) * D * EW; K = EW; N = D; }
    else if (id == 4) { W = p.in[12]; gain = p.in[11]; WT = (bf16_t*)(ws + OFF_WKV); K = D; N = 1024; }
    else if (id < 7) { W = p.in[14] + (size_t)(id - 5) * D * 8192; gain = p.in[13] + (id - 5) * D; WT = (bf16_t*)(ws + OFF_WIN_B) + (size_t)(id - 5) * 8192 * D; K = D; N = 8192; }
    else { W = p.in[16] + (size_t)(id - 7) * EW * D; WT = (bf16_t*)(ws + OFF_WOUT_B) + (size_t)(id - 7) * D * EW; K = EW; N = D; }
    const int nitems = (K / 64) * (N / 32);
    LAS float* scr = (LAS float*)(lds + wave * 8448);
    const int nblk = N / 32;
    f32x4 va[8], vb[8];
    int it = wslot;
    if (it < nitems) tr_load(W, N, nblk, it, lane, va);
    while (it < nitems) {
        const int it2 = it + nslots;
        if (it2 < nitems) tr_load(W, N, nblk, it2, lane, vb);
        tr_store(va, K, nblk, gain, WT, mapkind, scr, it, lane);
        if (it2 >= nitems) break;
        const int it3 = it2 + nslots;
        if (it3 < nitems) tr_load(W, N, nblk, it3, lane, va);
        tr_store(vb, K, nblk, gain, WT, mapkind, scr, it2, lane);
        it = it3;
    }
}
DI void convert_set(LAS unsigned char* lds, const Params& p, int set, int wslot, int nslots, int lane, int wave) {
    if (set == 0) convert_matrix(lds, p, 0, wslot, nslots, lane, wave);
    else if (set == 1) { convert_matrix(lds, p, 2, wslot, nslots, lane, wave); convert_matrix(lds, p, 3, wslot, nslots, lane, wave); convert_matrix(lds, p, 1, wslot, nslots, lane, wave); }
    else { for (int id = 4; id < 9; ++id) convert_matrix(lds, p, id, wslot, nslots, lane, wave); }
}

DI void norm_row(const float* src, float* xcopy, bf16_t* xb, float* y, const float* gain, int lane, float* ssout = nullptr) {
    const f32x4* xr = (const f32x4*)src + lane;
    f32x4 v[8]; float s = 0.f;
#pragma unroll
    for (int j = 0; j < 8; ++j) { v[j] = xr[64 * j]; s += (v[j].x * v[j].x + v[j].y * v[j].y) + (v[j].z * v[j].z + v[j].w * v[j].w); }
    const float tot = wave_sum(s);
    float rstd = __builtin_amdgcn_rsqf(tot * (1.f / D) + EPS);
    if (ssout) { if (lane == 0) *ssout = tot; rstd = 1.f; }
    if (xcopy) { f32x4* xc = (f32x4*)xcopy + lane;
#pragma unroll
        for (int j = 0; j < 8; ++j) xc[64 * j] = v[j]; }
    if (xb) { u32x2* o = (u32x2*)xb + lane;
#pragma unroll
        for (int j = 0; j < 8; ++j) { u32x2 w = {pk2(v[j].x * rstd, v[j].y * rstd), pk2(v[j].z * rstd, v[j].w * rstd)}; o[64 * j] = w; } }
    if (y) { f32x4* o = (f32x4*)y + lane; const f32x4* gr = (const f32x4*)gain + lane;
#pragma unroll
        for (int j = 0; j < 8; ++j) { const f32x4 gg = gr[64 * j]; o[64 * j] = v[j] * rstd * gg; } }
}

constexpr int S2_PBUF = 27648, S2_KE = 8448, S2_KET = 16896, S2_EL = 27136;
constexpr int S2_V = 55296, S2_OT = 88064, S2_ON = 154624;
DI void scan_phase(LAS unsigned char* lds, const Params& p, int layer, bool do_conv, const bf16_t* Qb, const bf16_t* Kb, const float* LF, const bf16_t* VT, const bf16_t* Gb, bf16_t* OG) {
    int tid = threadIdx.x; asm volatile("" : "+v"(tid));
    const int lane = tid & 63, w = __builtin_amdgcn_readfirstlane(tid >> 6), c = lane & 15, g = lane >> 4;
    const int G = gridDim.x, bid = blockIdx.x;
    int first, stride;
    if (G >= 128) { if (bid < 64) { first = bid; stride = 1 << 20; } else { first = 64 + (bid - 64); stride = G - 64; } } else { first = bid; stride = G; }
    if (tid < 256) ((LAS float*)(lds + S2_ON))[tid] = p.in[9][layer * 256 + tid];
    if (w < 4) {
    for (int item = first; item < 576; item += stride) {
        const bool isP = item < 64;
        int b, h, rowbase, ntok;
        if (isP) { b = item >> 4; h = item & 15; rowbase = b * TP; ntok = TP; } else { const int s = item - 64; b = s >> 4; h = s & 15; rowbase = NPR + b * 8; ntok = 8; }
        const int nsteps = (ntok + 31) >> 5;
            const int cw = w;
            f32x4 S[8][4];
            if (isP) {
#pragma unroll
                for (int i = 0; i < 8; ++i)
#pragma unroll
                    for (int dvt = 0; dvt < 4; ++dvt) S[i][dvt] = (f32x4){0.f, 0.f, 0.f, 0.f};
            } else {
                const float* sp = p.in[2] + (size_t)((layer * 32 + b) * 16 + h) * 32768 + 64 * cw + c;
#pragma unroll
                for (int i = 0; i < 8; ++i)
#pragma unroll
                    for (int dvt = 0; dvt < 4; ++dvt)
#pragma unroll
                        for (int j = 0; j < 4; ++j) S[i][dvt][j] = sp[(size_t)(16 * i + 4 * g + j) * 256 + 16 * dvt];
            }
            const int niter = (nsteps + 3) & ~1;
            for (int it = 0; it < niter; ++it) {
                if (it >= 1 && it <= nsteps) {
                    const int par = (it - 1) & 1;
                    LAS unsigned char* pbuf = lds + par * S2_PBUF;
                    LAS unsigned char* vbuf = lds + S2_V + par * 16384;
                    LAS float* OT = (LAS float*)(lds + S2_OT + par * 33280);
                    const int swz = (c >> 2) & 3;
                    f32x4 a00 = {0.f, 0.f, 0.f, 0.f}, a01 = a00, a11 = a00;
#pragma unroll
                    for (int kk = 0; kk < 4; ++kk) {
                        bf16x8 qe[2], ke[2];
#pragma unroll
                        for (int mt = 0; mt < 2; ++mt) {
                            const int off = (16 * mt + c) * 264 + (32 * kk + 4 * g) * 2;
                            const u32x2 q0 = *(const LAS u32x2*)(pbuf + off), q1 = *(const LAS u32x2*)(pbuf + off + 32);
                            const u32x2 k0 = *(const LAS u32x2*)(pbuf + S2_KE + off), k1 = *(const LAS u32x2*)(pbuf + S2_KE + off + 32);
                            qe[mt] = __builtin_bit_cast(bf16x8, (u32x4){q0.x, q0.y, q1.x, q1.y});
                            ke[mt] = __builtin_bit_cast(bf16x8, (u32x4){k0.x, k0.y, k1.x, k1.y});
                        }
                        a00 = __builtin_amdgcn_mfma_f32_16x16x32_bf16(ke[0], qe[0], a00, 0, 0, 0);
                        a01 = __builtin_amdgcn_mfma_f32_16x16x32_bf16(ke[0], qe[1], a01, 0, 0, 0);
                        a11 = __builtin_amdgcn_mfma_f32_16x16x32_bf16(ke[1], qe[1], a11, 0, 0, 0);
                    }
#pragma unroll
                    for (int j = 0; j < 4; ++j) { const bool keep = (4 * g + j) <= c; a00[j] = keep ? a00[j] : 0.f; a11[j] = keep ? a11[j] : 0.f; }
                    const bf16x8 pa0 = __builtin_bit_cast(bf16x8, (u32x4){pk2(a00[0], a00[1]), pk2(a00[2], a00[3]), 0u, 0u});
                    const bf16x8 pa1 = __builtin_bit_cast(bf16x8, (u32x4){pk2(a01[0], a01[1]), pk2(a01[2], a01[3]), pk2(a11[0], a11[1]), pk2(a11[2], a11[3])});
                    __builtin_amdgcn_sched_barrier(0);
#pragma unroll
                    for (int dh = 0; dh < 2; ++dh) {
                        bf16x8 vreg[2];
#pragma unroll
                        for (int d = 0; d < 2; ++d) {
                            const int row = 64 * cw + 16 * (2 * dh + d) + c;
                            const u32x2 a = *(const LAS u32x2*)(vbuf + row * 64 + ((g ^ swz) * 8)), bq = *(const LAS u32x2*)(vbuf + row * 64 + (((4 + g) ^ swz) * 8));
                            vreg[d] = __builtin_bit_cast(bf16x8, (u32x4){a.x, a.y, bq.x, bq.y});
                        }
                        f32x4 o[2][2];
#pragma unroll
                        for (int mt = 0; mt < 2; ++mt) { o[mt][0] = (f32x4){0.f, 0.f, 0.f, 0.f}; o[mt][1] = (f32x4){0.f, 0.f, 0.f, 0.f}; }
#pragma unroll
                        for (int kk = 0; kk < 4; ++kk) {
                            bf16x8 qe[2];
#pragma unroll
                            for (int mt = 0; mt < 2; ++mt) {
                                const int off = (16 * mt + c) * 264 + (32 * kk + 4 * g) * 2;
                                const u32x2 q0 = *(const LAS u32x2*)(pbuf + off), q1 = *(const LAS u32x2*)(pbuf + off + 32);
                                qe[mt] = __builtin_bit_cast(bf16x8, (u32x4){q0.x, q0.y, q1.x, q1.y});
                            }
#pragma unroll
                            for (int d = 0; d < 2; ++d) {
                                const f32x4 s0 = S[2 * kk][2 * dh + d], s1 = S[2 * kk + 1][2 * dh + d];
                                const bf16x8 sb = __builtin_bit_cast(bf16x8, (u32x4){pk2(s0[0], s0[1]), pk2(s0[2], s0[3]), pk2(s1[0], s1[1]), pk2(s1[2], s1[3])});
                                o[0][d] = __builtin_amdgcn_mfma_f32_16x16x32_bf16(qe[0], sb, o[0][d], 0, 0, 0);
                                o[1][d] = __builtin_amdgcn_mfma_f32_16x16x32_bf16(qe[1], sb, o[1][d], 0, 0, 0);
                            }
                        }
#pragma unroll
                        for (int d = 0; d < 2; ++d) {
                            o[0][d] = __builtin_amdgcn_mfma_f32_16x16x32_bf16(pa0, vreg[d], o[0][d], 0, 0, 0);
                            o[1][d] = __builtin_amdgcn_mfma_f32_16x16x32_bf16(pa1, vreg[d], o[1][d], 0, 0, 0);
                        }
#pragma unroll
                        for (int i = 0; i < 8; ++i) {
                            const u32x2 t0 = *(const LAS u32x2*)(pbuf + S2_KET + (16 * i + c) * 80 + 8 * g), t1 = *(const LAS u32x2*)(pbuf + S2_KET + (16 * i + c) * 80 + 32 + 8 * g);
                            const bf16x8 kt = __builtin_bit_cast(bf16x8, (u32x4){t0.x, t0.y, t1.x, t1.y});
                            const f32x4 el = *(const LAS f32x4*)(pbuf + S2_EL + (16 * i + 4 * g) * 4);
#pragma unroll
                            for (int d = 0; d < 2; ++d) { S[i][2 * dh + d] = __builtin_amdgcn_mfma_f32_16x16x32_bf16(kt, vreg[d], S[i][2 * dh + d], 0, 0, 0); S[i][2 * dh + d] = S[i][2 * dh + d] * el; }
                        }
#pragma unroll
                        for (int mt = 0; mt < 2; ++mt)
#pragma unroll
                            for (int d = 0; d < 2; ++d)
#pragma unroll
                                for (int j = 0; j < 4; ++j) OT[(16 * mt + 4 * g + j) * 260 + 64 * cw + 16 * (2 * dh + d) + c] = o[mt][d][j];
                        __builtin_amdgcn_sched_barrier(0);
                    }
                }
                lds_barrier();
            }
            {
                float* sp = p.out + (isP ? O_SP + (size_t)((layer * 4 + b) * 16 + h) * 32768 : O_SS + (size_t)((layer * 32 + b) * 16 + h) * 32768) + 64 * cw + c;
#pragma unroll
                for (int i = 0; i < 8; ++i)
#pragma unroll
                    for (int dvt = 0; dvt < 4; ++dvt)
#pragma unroll
                        for (int j = 0; j < 4; ++j) sp[(size_t)(16 * i + 4 * g + j) * 256 + 16 * dvt] = S[i][dvt][j];
            }
    }
    } else {
    for (int item = first; item < 576; item += stride) {
        const bool isP = item < 64;
        int b, h, rowbase, ntok;
        if (isP) { b = item >> 4; h = item & 15; rowbase = b * TP; ntok = TP; } else { const int s = item - 64; b = s >> 4; h = s & 15; rowbase = NPR + b * 8; ntok = 8; }
        const int nsteps = (ntok + 31) >> 5;
            const int pw = w - 4, pt = tid - 256;
            const int ch0 = 2 * (16 * pw + c), tg = g;
            const int ntk = pt >> 3, nsg = pt & 7;
            f32x2 Rlf[2][8]; unsigned Rq[2][8], Rk[2][8]; u32x4 Rv[2][4]; u32x2 Rg[2][8];
            const int niter = (nsteps + 3) & ~1;
#pragma unroll
            for (int hf = 0; hf < 2; ++hf) {
                const int pc = hf < nsteps - 1 ? hf : nsteps - 1;
                const size_t o = (size_t)(rowbase + 32 * pc + 8 * tg) * D + h * 128 + ch0;
#pragma unroll
                for (int i = 0; i < 8; ++i) { Rlf[hf][i] = *(const f32x2*)(LF + o + (size_t)i * D); Rq[hf][i] = *(const unsigned*)(Qb + o + (size_t)i * D); Rk[hf][i] = *(const unsigned*)(Kb + o + (size_t)i * D); }
                const bf16_t* vp = VT + (size_t)(h * 256 + pt) * MP + rowbase + 32 * pc;
#pragma unroll
                for (int q = 0; q < 4; ++q) Rv[hf][q] = *(const u32x4*)(vp + 8 * q);
#pragma unroll
                for (int e = 0; e < 8; ++e) Rg[hf][e] = (u32x2){0u, 0u};
            }
            __builtin_amdgcn_s_setprio(2);
            for (int it0 = 0; it0 < niter; it0 += 2) {
#pragma unroll
                for (int hf = 0; hf < 2; ++hf) {
                    const int it = it0 + hf;
                    {
                        const int pc = it < nsteps - 1 ? it : nsteps - 1;
                        const int tok0 = 32 * pc, nvalid = (ntok - tok0) < 32 ? (ntok - tok0) : 32;
                        LAS unsigned char* pbuf = lds + hf * S2_PBUF;
                        LAS unsigned char* vbuf = lds + S2_V + hf * 16384;
                        {
                            const int nc = it >= 2 ? it - 2 : 0;
                            const int ntok0 = 32 * nc; int nvn = (ntok - ntok0) < 32 ? (ntok - ntok0) : 32; if (it < 2 || nc >= nsteps) nvn = 0;
                            const LAS float* OT = (const LAS float*)(lds + S2_OT + hf * 33280);
                            f32x4 ov[8]; float ss = 0.f;
#pragma unroll
                            for (int e = 0; e < 8; ++e) { ov[e] = *(const LAS f32x4*)(OT + ntk * 260 + 4 * nsg + 32 * e); ss += (ov[e].x * ov[e].x + ov[e].y * ov[e].y) + (ov[e].z * ov[e].z + ov[e].w * ov[e].w); }
                            ss += __shfl_xor(ss, 1); ss += __shfl_xor(ss, 2); ss += __shfl_xor(ss, 4);
                            const float rstd = __builtin_amdgcn_rsqf(ss * (1.f / 256.f) + EPS);
                            const int orow = ntk < nvn ? rowbase + ntok0 + ntk : MT + ntk;
                            const size_t ro = (size_t)orow * EW + h * 256 + 4 * nsg;
#pragma unroll
                            for (int e = 0; e < 8; ++e) {
                                const u32x2 gg = Rg[hf][e];
                                u32x2 wv = {pk2(ov[e].x * rstd * bflo(gg.x), ov[e].y * rstd * bfhi(gg.x)), pk2(ov[e].z * rstd * bflo(gg.y), ov[e].w * rstd * bfhi(gg.y))};
                                *(u32x2*)(OG + ro + 32 * e) = wv;
                            }
                        }
                        {
                            const size_t ro = (size_t)(rowbase + tok0 + ntk) * EW + h * 256 + 4 * nsg;
#pragma unroll
                            for (int e = 0; e < 8; ++e) Rg[hf][e] = *(const u32x2*)(Gb + ro + 32 * e);
                        }
                        float cs[8][2], kv[8][2], qv[8][2]; float r0 = 0.f, r1 = 0.f;
                        if (nvalid >= 32) {
#pragma unroll
                            for (int i = 0; i < 8; ++i) { r0 += Rlf[hf][i].x; r1 += Rlf[hf][i].y; cs[i][0] = r0; cs[i][1] = r1; kv[i][0] = bflo(Rk[hf][i]); kv[i][1] = bfhi(Rk[hf][i]); }
                        } else {
#pragma unroll
                            for (int i = 0; i < 8; ++i) { const bool ok = (8 * tg + i) < nvalid; r0 += ok ? Rlf[hf][i].x : 0.f; r1 += ok ? Rlf[hf][i].y : 0.f; cs[i][0] = r0; cs[i][1] = r1;
                                kv[i][0] = ok ? bflo(Rk[hf][i]) : 0.f; kv[i][1] = ok ? bfhi(Rk[hf][i]) : 0.f; }
                        }
#pragma unroll
                        for (int i = 0; i < 8; ++i) { qv[i][0] = bflo(Rq[hf][i]); qv[i][1] = bfhi(Rq[hf][i]); }
                        {
                            const int swz = (pt >> 2) & 3;
#pragma unroll
                            for (int q = 0; q < 4; ++q) {
                                const u32x4 v = Rv[hf][q];
                                *(LAS u32x2*)(vbuf + pt * 64 + (((2 * q) ^ swz) * 8)) = (u32x2){v.x, v.y};
                                *(LAS u32x2*)(vbuf + pt * 64 + (((2 * q + 1) ^ swz) * 8)) = (u32x2){v.z, v.w};
                            }
                        }
                        {
                            const int nc2 = (it + 2) < nsteps - 1 ? (it + 2) : nsteps - 1;
                            const size_t o = (size_t)(rowbase + 32 * nc2 + 8 * tg) * D + h * 128 + ch0;
#pragma unroll
                            for (int i = 0; i < 8; ++i) { Rlf[hf][i] = *(const f32x2*)(LF + o + (size_t)i * D); Rq[hf][i] = *(const unsigned*)(Qb + o + (size_t)i * D); Rk[hf][i] = *(const unsigned*)(Kb + o + (size_t)i * D); }
                            const bf16_t* vp = VT + (size_t)(h * 256 + pt) * MP + rowbase + 32 * nc2;
#pragma unroll
                            for (int q = 0; q < 4; ++q) Rv[hf][q] = *(const u32x4*)(vp + 8 * q);
                        }
                        float i0 = r0, i1 = r1;
                        { const float t0 = __shfl_up(i0, 16), t1 = __shfl_up(i1, 16); if (tg >= 1) { i0 += t0; i1 += t1; } }
                        { const float t0 = __shfl_up(i0, 32), t1 = __shfl_up(i1, 32); if (tg >= 2) { i0 += t0; i1 += t1; } }
                        const float last0 = __shfl(i0, 48 + c), last1 = __shfl(i1, 48 + c);
                        const float e0 = i0 - r0, e1 = i1 - r1;
                        unsigned ka[8];
#pragma unroll
                        for (int i = 0; i < 8; ++i) {
                            const float c0 = e0 + cs[i][0], c1 = e1 + cs[i][1];
                            const unsigned qp = pk2(qv[i][0] * __builtin_amdgcn_exp2f(c0), qv[i][1] * __builtin_amdgcn_exp2f(c1));
                            const unsigned kp = pk2(kv[i][0] * __builtin_amdgcn_exp2f(-c0), kv[i][1] * __builtin_amdgcn_exp2f(-c1));
                            *(LAS unsigned*)(pbuf + (8 * tg + i) * 264 + ch0 * 2) = qp;
                            *(LAS unsigned*)(pbuf + S2_KE + (8 * tg + i) * 264 + ch0 * 2) = kp;
                            ka[i] = kp;
                        }
                        *(LAS u32x4*)(pbuf + S2_KET + ch0 * 80 + 16 * tg) = (u32x4){__builtin_amdgcn_perm(ka[1], ka[0], 0x05040100u), __builtin_amdgcn_perm(ka[3], ka[2], 0x05040100u), __builtin_amdgcn_perm(ka[5], ka[4], 0x05040100u), __builtin_amdgcn_perm(ka[7], ka[6], 0x05040100u)};
                        *(LAS u32x4*)(pbuf + S2_KET + (ch0 + 1) * 80 + 16 * tg) = (u32x4){__builtin_amdgcn_perm(ka[1], ka[0], 0x07060302u), __builtin_amdgcn_perm(ka[3], ka[2], 0x07060302u), __builtin_amdgcn_perm(ka[5], ka[4], 0x07060302u), __builtin_amdgcn_perm(ka[7], ka[6], 0x07060302u)};
                        if (tg == 0) { *(LAS float*)(pbuf + S2_EL + ch0 * 4) = __builtin_amdgcn_exp2f(last0); *(LAS float*)(pbuf + S2_EL + ch0 * 4 + 4) = __builtin_amdgcn_exp2f(last1); }
                        lds_barrier();
                    }
                }
            }
            __builtin_amdgcn_s_setprio(0);
    }
    }
    {
        int wslot = -1, nslots = 0;
        if (G >= 128) { if (bid >= 64) { wslot = (bid - 64) * 8 + w; nslots = (G - 64) * 8; } } else { wslot = bid * 8 + w; nslots = G * 8; }
        if (wslot >= 0 && do_conv) { __syncthreads(); convert_set(lds, p, layer + 1, wslot, nslots, lane, w); }
    }
}

constexpr int AT_K = 0, AT_V = 23040;
template <bool PRE>
DI void attn_compute(LAS unsigned char* lds, const bf16_t* QA, const bf16_t* GA, bf16_t* OA, bool isP, int t0, int qrowbase, int hh, float slope, float sink, int c, int g,
                     const bf16x8 (&qpre)[2][2], const u32x2 (&gpre)[2][4]) {
#pragma unroll
    for (int qt = 0; qt < 2; ++qt) {
        bf16x8 qf[2];
#pragma unroll
        for (int kk = 0; kk < 2; ++kk) qf[kk] = PRE ? qpre[qt][kk] : *(const bf16x8*)(QA + (size_t)(qrowbase + 16 * qt + c) * EW + hh * 64 + 32 * kk + 8 * g);
        f32x4 sT[10];
#pragma unroll
        for (int kt = 0; kt < 10; ++kt) {
            if (kt == (qt == 0 ? 9 : 0)) { sT[kt] = (f32x4){0.f, 0.f, 0.f, 0.f}; continue; }
            const bf16x8 k0 = *(const LAS bf16x8*)(lds + AT_K + (16 * kt + c) * 144 + 16 * g), k1 = *(const LAS bf16x8*)(lds + AT_K + (16 * kt + c) * 144 + 64 + 16 * g);
            f32x4 a = {0.f, 0.f, 0.f, 0.f};
            a = __builtin_amdgcn_mfma_f32_16x16x32_bf16(k0, qf[0], a, 0, 0, 0); a = __builtin_amdgcn_mfma_f32_16x16x32_bf16(k1, qf[1], a, 0, 0, 0); sT[kt] = a;
            if (kt & 1) __builtin_amdgcn_sched_barrier(0);
        }
        float m = -1e30f;
        const int dbase = 128 + 16 * qt + c - 4 * g;
        const int kmin = isP ? (128 - t0 - 4 * g) : -1000;
        const float sb = slope * (float)dbase;
        if (!isP || t0 >= 128) {
#pragma unroll
            for (int kt = 0; kt < 10; ++kt) {
                if (kt == (qt == 0 ? 9 : 0)) continue;
                const bool inner = (kt >= 1 + qt) && (kt <= 7 + qt);
#pragma unroll
                for (int j = 0; j < 4; ++j) { const int cst = 16 * kt + j; const int dist = dbase - cst;
                    const bool valid = inner ? true : ((unsigned)dist < 128u);
                    const float x = valid ? (sT[kt][j] - sb) + slope * (float)cst : -1e30f; sT[kt][j] = x; m = fmaxf(m, x); }
            }
        } else {
#pragma unroll
            for (int kt = 0; kt < 10; ++kt) {
                if (kt == (qt == 0 ? 9 : 0)) continue;
#pragma unroll
                for (int j = 0; j < 4; ++j) { const int cst = 16 * kt + j; const int dist = dbase - cst;
                    const bool valid = ((unsigned)dist < 128u) && (cst >= kmin);
                    const float x = valid ? (sT[kt][j] - sb) + slope * (float)cst : -1e30f; sT[kt][j] = x; m = fmaxf(m, x); }
            }
        }
        m = fmaxf(m, __shfl_xor(m, 16)); m = fmaxf(m, __shfl_xor(m, 32)); m = fmaxf(m, sink);
        float l = 0.f;
#pragma unroll
        for (int kt = 0; kt < 10; ++kt) {
            if (kt == (qt == 0 ? 9 : 0)) continue;
#pragma unroll
            for (int j = 0; j < 4; ++j) { const float pv = __builtin_amdgcn_exp2f(sT[kt][j] - m); sT[kt][j] = pv; l += pv; }
        }
        l += __shfl_xor(l, 16); l += __shfl_xor(l, 32); l += __builtin_amdgcn_exp2f(sink - m);
        const float inv = 1.f / l;
        f32x4 oT[4];
#pragma unroll
        for (int dt = 0; dt < 4; ++dt) oT[dt] = (f32x4){0.f, 0.f, 0.f, 0.f};
#pragma unroll
        for (int ks = 0; ks < 5; ++ks) {
            const f32x4 s0 = sT[2 * ks], s1 = sT[2 * ks + 1];
            const bf16x8 pb = __builtin_bit_cast(bf16x8, (u32x4){pk2(s0[0], s0[1]), pk2(s0[2], s0[3]), pk2(s1[0], s1[1]), pk2(s1[2], s1[3])});
#pragma unroll
            for (int dt = 0; dt < 4; ++dt) {
                const u32x2 v0 = *(const LAS u32x2*)(lds + AT_V + (16 * dt + c) * 336 + (32 * ks + 4 * g) * 2), v1 = *(const LAS u32x2*)(lds + AT_V + (16 * dt + c) * 336 + (32 * ks + 16 + 4 * g) * 2);
                const bf16x8 vf = __builtin_bit_cast(bf16x8, (u32x4){v0.x, v0.y, v1.x, v1.y});
                oT[dt] = __builtin_amdgcn_mfma_f32_16x16x32_bf16(vf, pb, oT[dt], 0, 0, 0);
            }
            __builtin_amdgcn_sched_barrier(0);
        }
        const int qidx = 16 * qt + c; const bool ok = isP ? (t0 + qidx < TP) : (qidx < 8);
        if (ok) {
            const size_t ro = (size_t)(qrowbase + qidx) * EW + hh * 64 + 4 * g;
#pragma unroll
            for (int dt = 0; dt < 4; ++dt) { const u32x2 gt = PRE ? gpre[qt][dt] : *(const u32x2*)(GA + ro + 16 * dt); const f32x4 ov = oT[dt] * inv;
                u32x2 wv = {pk2(ov[0] * bflo(gt.x), ov[1] * bfhi(gt.x)), pk2(ov[2] * bflo(gt.y), ov[3] * bfhi(gt.y))}; *(u32x2*)(OA + ro + 16 * dt) = wv; }
        }
        __builtin_amdgcn_sched_barrier(0);
    }
}

DI void attn_kv_load(const bf16_t* KS, const bf16_t* VTS, int u, int tid, u32x4 (&kr)[3], u32x4 (&vr)[3]) {
    const int b = u / 520, rem = u - b * 520, kvh = rem / 65, t0 = 32 * (rem - kvh * 65);
#pragma unroll
    for (int r = 0; r < 3; ++r) {
        int q = tid + 512 * r; q = q < 1280 ? q : 1279;
        const int key = q >> 3, part = q & 7; int s = t0 - 128 + key; s = s < 0 ? 0 : s;
        kr[r] = *(const u32x4*)(KS + (size_t)(b * TP + s) * 512 + kvh * 64 + part * 8);
        const int d = q / 20, chn = q - d * 20; int s0 = t0 - 128 + 8 * chn; s0 = s0 < 0 ? 0 : s0;
        vr[r] = *(const u32x4*)(VTS + (size_t)(kvh * 64 + d) * MP + b * TP + s0);
    }
}
DI void attn_kv_store(LAS unsigned char* lds, int u, int tid, const u32x4 (&kr)[3], const u32x4 (&vr)[3]) {
    const int b = u / 520, rem = u - b * 520, kvh = rem / 65, t0 = 32 * (rem - kvh * 65);
#pragma unroll
    for (int r = 0; r < 3; ++r) {
        const int q = tid + 512 * r;
        if (q < 1280) {
            const int key = q >> 3, part = q & 7, s = t0 - 128 + key;
            *(LAS u32x4*)(lds + AT_K + key * 144 + part * 16) = s >= 0 ? kr[r] : (u32x4){0u, 0u, 0u, 0u};
            const int d = q / 20, chn = q - d * 20, s0 = t0 - 128 + 8 * chn;
            *(LAS u32x4*)(lds + AT_V + d * 336 + chn * 16) = s0 >= 0 ? vr[r] : (u32x4){0u, 0u, 0u, 0u};
        }
    }
}

DI void attn_phase(LAS unsigned char* lds, const Params& p, int layer, const bf16_t* QA, const bf16_t* KS, const bf16_t* VTS, const bf16_t* GA, bf16_t* OA) {
    int tid = threadIdx.x; asm volatile("" : "+v"(tid));
    const int lane = tid & 63, w = __builtin_amdgcn_readfirstlane(tid >> 6), c = lane & 15, g = lane >> 4;
    const int G = gridDim.x;
    {
        u32x4 kr[3], vr[3];
        int u = blockIdx.x;
        if (u < 2080) attn_kv_load(KS, VTS, u, tid, kr, vr);
        for (; u < 2080; u += G) {
            const int b = u / 520, rem = u - b * 520, kvh = rem / 65, t0 = 32 * (rem - kvh * 65), qrowbase = b * TP + t0;
            const int hh = kvh * 8 + w;
            bf16x8 qpre[2][2]; u32x2 gpre[2][4];
#pragma unroll
            for (int qt = 0; qt < 2; ++qt) {
#pragma unroll
                for (int kk = 0; kk < 2; ++kk) qpre[qt][kk] = *(const bf16x8*)(QA + (size_t)(qrowbase + 16 * qt + c) * EW + hh * 64 + 32 * kk + 8 * g);
#pragma unroll
                for (int dt = 0; dt < 4; ++dt) gpre[qt][dt] = *(const u32x2*)(GA + (size_t)(qrowbase + 16 * qt + c) * EW + hh * 64 + 4 * g + 16 * dt);
            }
            lds_barrier();
            attn_kv_store(lds, u, tid, kr, vr);
            const int un = (u + G) < 2080 ? (u + G) : u;
            attn_kv_load(KS, VTS, un, tid, kr, vr);
            lds_barrier();
            const float slope = exp2f(-(float)(hh + 1) * 0.125f) * 1.4426950408889634f, sink = p.in[15][layer * 64 + hh] * 1.4426950408889634f;
            attn_compute<true>(lds, QA, GA, OA, true, t0, qrowbase, hh, slope, sink, c, g, qpre, gpre);
        }
    }
    for (int u = 2080 + blockIdx.x; u < 2336; u += G) {
        const int s = u - 2080, b = s >> 3, kvh = s & 7, qrowbase = NPR + 8 * b;
        __syncthreads();
        {
            const float* ck = p.in[3]; const float* cv = p.in[4];
            for (int q = tid; q < 1280; q += 512) {
                const int key = q >> 3, part = q & 7;
                u32x4 v = {0u, 0u, 0u, 0u};
                if (key < 128) { const f32x4* src = (const f32x4*)(ck + (size_t)((b * 128 + key) * 8 + kvh) * 64 + part * 8); const f32x4 x0 = src[0], x1 = src[1];
                    v = (u32x4){pk2(x0.x, x0.y), pk2(x0.z, x0.w), pk2(x1.x, x1.y), pk2(x1.z, x1.w)}; }
                else if (key < 136) v = *(const u32x4*)(KS + (size_t)(NPR + 8 * b + key - 128) * 512 + kvh * 64 + part * 8);
                *(LAS u32x4*)(lds + AT_K + key * 144 + part * 16) = v;
            }
            for (int q = tid; q < 1280; q += 512) {
                const int d = q & 63, chn = q >> 6;
                u32x4 v = {0u, 0u, 0u, 0u};
                if (chn < 16) { float x[8];
#pragma unroll
                    for (int e = 0; e < 8; ++e) x[e] = cv[(size_t)((b * 128 + 8 * chn + e) * 8 + kvh) * 64 + d];
                    v = (u32x4){pk2(x[0], x[1]), pk2(x[2], x[3]), pk2(x[4], x[5]), pk2(x[6], x[7])}; }
                else if (chn == 16) v = *(const u32x4*)(VTS + (size_t)(kvh * 64 + d) * MP + NPR + 8 * b);
                *(LAS u32x4*)(lds + AT_V + d * 336 + chn * 16) = v;
            }
        }
        __syncthreads();
        const int hh = kvh * 8 + w;
        const float slope = exp2f(-(float)(hh + 1) * 0.125f) * 1.4426950408889634f, sink = p.in[15][layer * 64 + hh] * 1.4426950408889634f;
        bf16x8 qd[2][2]; u32x2 gd[2][4];
#pragma unroll
        for (int qt = 0; qt < 2; ++qt) {
#pragma unroll
            for (int kk = 0; kk < 2; ++kk) qd[qt][kk] = (bf16x8){0, 0, 0, 0, 0, 0, 0, 0};
#pragma unroll
            for (int dt = 0; dt < 4; ++dt) gd[qt][dt] = (u32x2){0u, 0u};
        }
        attn_compute<false>(lds, QA, GA, OA, false, 0, qrowbase, hh, slope, sink, c, g, qd, gd);
    }
}

#define XB_TMO      128
#define XB_XCNT(j)  (256  + 64 * (j))
#define XB_XSUB(j)  (1280 + 64 * (j))
#define XB_XGEN(j)  (2304 + 64 * (j))
#define XB_TOP      3328
#define XB_TOPGEN   3392
#define XCD_BAR_WORDS 3456
#define XB_SPIN_CAP (1u << 18)

__device__ __forceinline__ unsigned xb_ld(unsigned* p)              { return __hip_atomic_load(p, __ATOMIC_RELAXED, __HIP_MEMORY_SCOPE_AGENT); }
__device__ __forceinline__ unsigned xb_add(unsigned* p, unsigned v) { return __hip_atomic_fetch_add(p, v, __ATOMIC_RELAXED, __HIP_MEMORY_SCOPE_AGENT); }
__device__ __forceinline__ unsigned xb_xcc_id() { return (unsigned)__builtin_amdgcn_s_getreg((3 << 11) | 20) & 0xFu; }
#define XB_SPIN(cond, bar) do { unsigned _sp = 0; while (cond) { __builtin_amdgcn_s_sleep(1); \
    if ((++_sp & 255u) == 0u) { if (xb_ld(&(bar)[XB_TMO])) break; if (_sp > XB_SPIN_CAP) { atomicAdd(&(bar)[XB_TMO], 1u); break; } } } } while (0)

struct XcdBarrier {
    unsigned* bar; unsigned x;
    volatile LAS unsigned* st;
};

__device__ __forceinline__ XcdBarrier xcd_barrier_post(unsigned* bar, volatile LAS unsigned* st) {
    XcdBarrier b; b.bar = bar; b.x = xb_xcc_id(); b.st = st;
    if (threadIdx.x == 0) (void)xb_add(&bar[XB_XCNT(b.x)], 1u);
    return b;
}
__device__ __forceinline__ void xcd_barrier_complete(unsigned* bar, unsigned x, unsigned& nloc, unsigned& nx) {
    const unsigned G = gridDim.x * gridDim.y * gridDim.z;
    unsigned sum, cnt, mine, sp = 0u;
    for (;;) {
        sum = 0u; cnt = 0u; mine = 0u;
#pragma unroll
        for (unsigned j = 0; j < 16; ++j) { const unsigned c = xb_ld(&bar[XB_XCNT(j)]); sum += c; cnt += (c > 0u) ? 1u : 0u; mine = (j == x) ? c : mine; }
        if (sum == G) break;
        __builtin_amdgcn_s_sleep(1);
        if ((++sp & 255u) == 0u) { if (xb_ld(&bar[XB_TMO])) break; if (sp > XB_SPIN_CAP) { atomicAdd(&bar[XB_TMO], 1u); break; } }
    }
    nloc = mine > 0u ? mine : 1u; nx = cnt > 0u ? cnt : 1u;
}

__device__ __forceinline__ void xcd_barrier(const XcdBarrier& b) {
    asm volatile("s_waitcnt vmcnt(0)" ::: "memory");
    __syncthreads();
    if (threadIdx.x == 0) {
        unsigned* bar = b.bar;
        __builtin_amdgcn_s_waitcnt(0);
        unsigned nloc = b.st[0], nx = b.st[1];
        if (nloc == 0u) { xcd_barrier_complete(bar, b.x, nloc, nx); b.st[0] = nloc; b.st[1] = nx; }
        const unsigned old = xb_add(&bar[XB_XSUB(b.x)], 1u);
        const unsigned gen = old / nloc;
        if (old + 1u == (gen + 1u) * nloc) {
            __builtin_amdgcn_fence(__ATOMIC_RELEASE, "agent");
            asm volatile("s_waitcnt vmcnt(0)" ::: "memory");
            const unsigned og = xb_add(&bar[XB_TOP], 1u);
            const unsigned tg = og / nx;
            if (og + 1u == (tg + 1u) * nx) xb_add(&bar[XB_TOPGEN], 1u);
            else XB_SPIN(xb_ld(&bar[XB_TOPGEN]) == tg, bar);
            __builtin_amdgcn_fence(__ATOMIC_ACQUIRE, "agent");
            xb_add(&bar[XB_XGEN(b.x)], 1u);
            asm volatile("s_waitcnt vmcnt(0)" ::: "memory");
        } else {
            XB_SPIN(xb_ld(&bar[XB_XGEN(b.x)]) == gen, bar);
            __builtin_amdgcn_fence(__ATOMIC_ACQUIRE, "agent");
            asm volatile("s_waitcnt vmcnt(0)" ::: "memory");
        }
    }
    __syncthreads();
}


DI void norm_phase(const Params& p, int mode) {
    int tid = threadIdx.x; asm volatile("" : "+v"(tid));
    const int lane = tid & 63, wave = __builtin_amdgcn_readfirstlane(tid >> 6);
    const int gw = blockIdx.x * 8 + wave, NGW = gridDim.x * 8;
    float* X = (float*)(p.ws + OFF_X); bf16_t* XB = (bf16_t*)(p.ws + OFF_XB);
    if (mode == 1) {
        const bf16_t* KS = (const bf16_t*)(p.ws + OFF_KS); const bf16_t* VTS = (const bf16_t*)(p.ws + OFF_VTS);
        const int gt = blockIdx.x * 512 + tid, NT = gridDim.x * 512;
        for (int i = gt; i < (512 + 256) * 512; i += NT) {
            const int r = i >> 9, col = i & 511;
            int row; size_t dk, dv;
            if (r < 512) { const int b = r >> 7, t = r & 127; row = b * TP + (TP - 128) + t; dk = O_CKP + (size_t)r * 512 + col; dv = O_CVP + (size_t)r * 512 + col; }
            else { const int s = r - 512; row = NPR + s; const size_t o = (size_t)((s >> 3) * 128 + 120 + (s & 7)) * 512 + col; dk = O_CKS + o; dv = O_CVS + o; }
            p.out[dk] = bf2f(KS[(size_t)row * 512 + col]);
            p.out[dv] = bf2f(VTS[(size_t)col * MP + row]);
        }
    }
    for (int m = gw; m < MT; m += NGW) {
        if (mode == 0) norm_row(X + (size_t)m * D, nullptr, XB + (size_t)m * D, nullptr, nullptr, lane);
        else if (mode == 1) {
            float* dst;
            if (m < NPR) { const int b = m / TP, t = m - b * TP; if (t < 16) continue; dst = p.out + O_YP + (size_t)(b * 2048 + t - 16) * D; }
            else dst = p.out + O_YS + (size_t)(m - NPR) * D;
            norm_row(X + (size_t)m * D, nullptr, nullptr, dst, p.in[17], lane);
        } else {
            const float* src;
            if (m < NPR) { const int b = m / TP, t = m - b * TP; src = t < 16 ? p.in[5] + (size_t)t * D : p.in[0] + (size_t)(b * 2048 + t - 16) * D; }
            else src = p.in[1] + (size_t)(m - NPR) * D;
            norm_row(src, X + (size_t)m * D, XB + (size_t)m * D, nullptr, nullptr, lane, (float*)(p.ws + OFF_SS) + m);
        }
    }
}

DI void reduce_phase(const Params& p, int ssidx) {
    int tid = threadIdx.x; asm volatile("" : "+v"(tid));
    const int lane = tid & 63, wave = __builtin_amdgcn_readfirstlane(tid >> 6);
    const int G = gridDim.x, NGW = G * 8;
    float* X = (float*)(p.ws + OFF_X); bf16_t* XB = (bf16_t*)(p.ws + OFF_XB); float* SS = (float*)(p.ws + OFF_SS) + (size_t)ssidx * MP; const float* P = (const float*)(p.ws + OFF_Q);
    for (int task = wave * G + (int)blockIdx.x; task < (MT - 8192) * 8; task += NGW) {
        const int r = 8192 + (task >> 3), j = task & 7;
        const int pmi = (r - 8192) >> 8, rr = (r - 8192) & 255;
        const float* pp = P + (size_t)((pmi * 8 + j) * 16) * 65536 + rr * 256 + lane * 4;
        f32x4 s = *(const f32x4*)(X + (size_t)r * D + j * 256 + lane * 4);
        f32x4 t[16];
#pragma unroll
        for (int kp = 0; kp < 16; ++kp) t[kp] = *(const f32x4*)(pp + (size_t)kp * 65536);
#pragma unroll
        for (int kp = 0; kp < 16; ++kp) s = s + t[kp];
        *(f32x4*)(X + (size_t)r * D + j * 256 + lane * 4) = s;
        *(u32x2*)(XB + (size_t)r * D + j * 256 + lane * 4) = (u32x2){pk2(s.x, s.y), pk2(s.z, s.w)};
        const float ss = wave_sum((s.x * s.x + s.y * s.y) + (s.z * s.z + s.w * s.w));
        if (lane == 0) __hip_atomic_fetch_add(SS + r, ss, __ATOMIC_RELAXED, __HIP_MEMORY_SCOPE_AGENT);
    }
}

DI void prologue_phase(LAS unsigned char* lds, const Params& p) {
    int tid = threadIdx.x; asm volatile("" : "+v"(tid));
    const int lane = tid & 63, wave = __builtin_amdgcn_readfirstlane(tid >> 6);
    const int G = gridDim.x, bid = blockIdx.x, gw = bid * 8 + wave, NGW = G * 8;
    float* LB = (float*)(p.ws + OFF_LB);
    convert_set(lds, p, 0, gw, NGW, lane, wave);
    const int gt = bid * 512 + tid, NT = G * 512;
    for (int i = gt; i < 4 * MP; i += NT) ((float*)(p.ws + OFF_SS))[MP + i] = 0.f;
    for (int i = gt; i < 2 * 2048; i += NT) { const int cc = i & 2047; LB[i] = i < 2048 ? 0.f : 1.f / (1.f + __expf(p.in[8][cc] - p.in[8][2048 + cc])); }
    for (int i = gt; i < 32 * 120 * 128; i += NT) { const int bs = i / (120 * 128), r = i - bs * (120 * 128);
        ((f32x4*)(p.out + O_CKS))[(size_t)bs * 128 * 128 + r] = ((const f32x4*)p.in[3])[(size_t)bs * 128 * 128 + 8 * 128 + r];
        ((f32x4*)(p.out + O_CVS))[(size_t)bs * 128 * 128 + r] = ((const f32x4*)p.in[4])[(size_t)bs * 128 * 128 + 8 * 128 + r]; }
}

__global__ void __launch_bounds__(512) yoco_fwd(Params p) {
    extern __shared__ __attribute__((aligned(16))) unsigned char lds_raw[];
    LAS unsigned char* lds = (LAS unsigned char*)lds_raw;
    cg::grid_group grid = cg::this_grid();
    if (threadIdx.x == 0) { ((volatile LAS unsigned*)(lds + LDS_ST))[0] = 0u; ((volatile LAS unsigned*)(lds + LDS_ST))[1] = 0u; }
    __syncthreads();
    const XcdBarrier xbar = xcd_barrier_post((unsigned*)(p.ws + OFF_CTL), (volatile LAS unsigned*)(lds + LDS_ST));
    constexpr int NPH = 18;
#pragma unroll 1
    for (int ph = 0; ph < NPH; ++ph) {
        int kind, arg;
        switch (ph) {
            case 0: kind = 0; arg = 0; break;
            case 1: kind = 2; arg = 0; break;   case 2: kind = 3; arg = 0; break;   case 3: kind = 4; arg = 0; break;   case 4: kind = 7; arg = 0; break;
            case 5: kind = 2; arg = 1; break;   case 6: kind = 3; arg = 1; break;   case 7: kind = 4; arg = 1; break;   case 8: kind = 7; arg = 1; break;
            case 9: kind = 5; arg = 0; break;   case 10: kind = 6; arg = 0; break;  case 11: kind = 4; arg = 2; break;  case 12: kind = 7; arg = 2; break;
            case 13: kind = 5; arg = 1; break;  case 14: kind = 6; arg = 1; break;  case 15: kind = 4; arg = 3; break;  case 16: kind = 7; arg = 3; break;
            default: kind = 1; arg = 1; break;
        }
        asm volatile("" : "+s"(kind), "+s"(arg));
        unsigned char* ws = p.ws;
        const int G = gridDim.x, bid = blockIdx.x;
        if (kind == 0) { prologue_phase(lds, p); norm_phase(p, 2); }
        else if (kind == 1) norm_phase(p, arg);
        else if (kind == 2) {
            const int l = arg;
            GSched S; S.X = (const char*)(ws + OFF_XB); S.W = (const char*)(ws + OFF_WIN_A) + (size_t)l * 12288 * D * 2; S.K = D; S.nM = 34; S.nN = 48; S.pn0 = 0; S.t0 = 32; S.t1 = 48; S.G = G; S.c = bid; S.split = 0;
            EpiHgrnIn E{(bf16_t*)(ws + OFF_Q), (bf16_t*)(ws + OFF_K), (float*)(ws + OFF_LF), (bf16_t*)(ws + OFF_VT), (bf16_t*)(ws + OFF_G), (const float*)(ws + OFF_LB) + l * 2048, (const float*)(ws + OFF_SS) + (size_t)l * MP, p.in[9] + l * 256};
            gemm_phase(lds, S, E);
        } else if (kind == 3) {
            scan_phase(lds, p, arg, true, (const bf16_t*)(ws + OFF_Q), (const bf16_t*)(ws + OFF_K), (const float*)(ws + OFF_LF), (const bf16_t*)(ws + OFF_VT), (const bf16_t*)(ws + OFF_G), (bf16_t*)(ws + OFF_OG));
        } else if (kind == 4) {
            GSched S; S.X = (const char*)(ws + OFF_OG); S.W = (const char*)(ws + (arg < 2 ? OFF_WOUT_A : OFF_WOUT_B)) + (size_t)(arg & 1) * D * EW * 2; S.K = EW; S.nM = 34; S.nN = 8; S.pn0 = 0; S.t0 = 0; S.t1 = 0; S.G = G; S.c = bid; S.split = 1;
            EpiOut E{(float*)(ws + OFF_X), (bf16_t*)(ws + OFF_XB), (float*)(ws + OFF_SS) + (size_t)(arg + 1) * MP, (float*)(ws + OFF_Q)};
            gemm_phase(lds, S, E);
        } else if (kind == 5) {
            const int l = arg;
            GSched S; S.X = (const char*)(ws + OFF_XB); S.W = (const char*)(ws + OFF_WKV) + (size_t)l * 8192 * D * 2; S.K = D; S.nM = 34; S.nN = l == 0 ? 36 : 32; S.pn0 = l == 0 ? 0 : 4; S.t0 = 2; S.t1 = 4; S.G = G; S.c = bid; S.split = 0;
            EpiSwaIn E{(bf16_t*)(ws + OFF_KS), (bf16_t*)(ws + OFF_VTS), (bf16_t*)(ws + OFF_Q), (bf16_t*)(ws + OFF_G), (const float*)(ws + OFF_SS) + (size_t)(2 + l) * MP};
            gemm_phase(lds, S, E);
        } else if (kind == 7) {
            reduce_phase(p, arg + 1);
        } else if (kind == 6) {
            attn_phase(lds, p, arg, (const bf16_t*)(ws + OFF_Q), (const bf16_t*)(ws + OFF_KS), (const bf16_t*)(ws + OFF_VTS), (const bf16_t*)(ws + OFF_G), (bf16_t*)(ws + OFF_OG));
        }
        if (ph + 1 < NPH) { if (gridDim.x == 0x7fffffffu) grid.sync(); else xcd_barrier(xbar); }
    }
}

extern "C" void kernel_launch(void* const* d_in, const int* in_sizes, int n_in, void* d_out, int out_size, void* d_ws, size_t ws_size, hipStream_t stream) {
    static int grid_blocks = 0;
    if (grid_blocks == 0) {
        if (n_in != 18 || ws_size < WS_END) { fprintf(stderr, "kernel_launch: unexpected n_in %d / ws_size %zu (need %zu)\n", n_in, ws_size, (size_t)WS_END); grid_blocks = -1; return; }
        int dev = 0, cus = 0, per_cu = 0;
        hipGetDevice(&dev);
        hipDeviceGetAttribute(&cus, hipDeviceAttributeMultiprocessorCount, dev);
        hipFuncSetAttribute((const void*)yoco_fwd, hipFuncAttributeMaxDynamicSharedMemorySize, LDS_BYTES);
        hipOccupancyMaxActiveBlocksPerMultiprocessor(&per_cu, (const void*)yoco_fwd, 512, LDS_BYTES);
        if (per_cu < 1) { fprintf(stderr, "kernel_launch: occupancy query returned %d\n", per_cu); per_cu = 1; }
        grid_blocks = cus * 1;
    }
    if (grid_blocks < 0) return;
    if (hipMemsetAsync((char*)d_ws + OFF_CTL, 0, CTL_BYTES, stream) != hipSuccess) { fprintf(stderr, "kernel_launch: memset of the barrier words failed\n"); return; }
    Params p{};
    for (int i = 0; i < 18; ++i) p.in[i] = (const float*)d_in[i];
    p.out = (float*)d_out; p.ws = (unsigned char*)d_ws;
    void* args[] = {&p};
    hipError_t e = hipLaunchCooperativeKernel((const void*)yoco_fwd, dim3(grid_blocks), dim3(512), args, LDS_BYTES, stream);
    if (e != hipSuccess) fprintf(stderr, "cooperative launch failed: %s (grid %d)\n", hipGetErrorString(e), grid_blocks);
}
```

```cpp
#include <hip/hip_runtime.h>
#include <hip/hip_cooperative_groups.h>
#include <cstdio>
#include <cstdint>
namespace cg = cooperative_groups;

#define LAS __attribute__((address_space(3)))
#define DI __device__ __forceinline__
typedef unsigned short bf16_t;
typedef short bf16x8 __attribute__((ext_vector_type(8)));
typedef float f32x4 __attribute__((ext_vector_type(4)));
typedef float f32x2 __attribute__((ext_vector_type(2)));
typedef unsigned u32x4 __attribute__((ext_vector_type(4)));
typedef unsigned u32x2 __attribute__((ext_vector_type(2)));
typedef __bf16 bf2_t __attribute__((ext_vector_type(2)));

constexpr int D = 2048, EW = 4096, TP = 2064, NPR = 8256, MT = 8512, MP = 8704;
constexpr float EPS = 1e-6f;
constexpr size_t O_YP = 0, O_YS = 16777216, O_SP = 17301504, O_CKP = 21495808, O_CVP = 21757952, O_SS = 22020096, O_CKS = 55574528, O_CVS = 57671680;
constexpr size_t OFF_WIN_A = 0, OFF_WOUT_A = 100663296, OFF_WKV = 134217728, OFF_WIN_B = 138412032, OFF_WOUT_B = 205520896,
                 OFF_X = 239075328, OFF_XB = 310378496, OFF_Q = 346030080, OFF_K = 381681664, OFF_LF = 417333248, OFF_VT = 488636416,
                 OFF_G = 559939584, OFF_OG = 631242752, OFF_KS = 702545920, OFF_VTS = 711458816, OFF_LB = 720371712, OFF_CTL = 720388096, CTL_BYTES = 16384, OFF_SS = 720404480, WS_END = 720404480 + 5 * 8704 * 4;
constexpr int LDS_BYTES = 155712, LDS_ST = 155648;

struct Params { const float* in[18]; float* out; unsigned char* ws; };

DI unsigned pk2(float a, float b) { f32x2 v = {a, b}; bf2_t r = __builtin_convertvector(v, bf2_t); return __builtin_bit_cast(unsigned, r); }
DI float bflo(unsigned u) { return __uint_as_float(u << 16); }
DI float bfhi(unsigned u) { return __uint_as_float(u & 0xffff0000u); }
DI float bf2f(bf16_t h) { return __uint_as_float((unsigned)h << 16); }
DI float fsilu(float v) { return v * __builtin_amdgcn_rcpf(1.f + __expf(-v)); }
DI void lds_barrier() { asm volatile("s_waitcnt lgkmcnt(0)" ::: "memory"); __builtin_amdgcn_s_barrier(); asm volatile("" ::: "memory"); }
DI float wave_sum(float v) {
#pragma unroll
    for (int o = 1; o < 64; o <<= 1) v += __shfl_xor(v, o);
    return v;
}

constexpr int BM = 256, BK = 64, HALF = 128, HTB = HALF * BK * 2;
DI int lds_byte(int r, int c) { const int st = (r >> 4) * 2 + (c >> 5), rr = r & 15, cc = c & 31, ob = rr * 64 + cc * 2; return st * 1024 + (ob ^ (((ob >> 9) & 1) << 5)); }
DI void stage_rc(int b, int& R, int& C) { const int st = b / 1024, sb = b % 1024, swz = sb ^ (((sb >> 9) & 1) << 5); R = (st >> 1) * 16 + swz / 64; C = (st & 1) * 32 + (swz % 64) / 2; }
DI int perm32(int rho) { const int n = rho >> 4, i = rho & 15; return 8 * (i >> 2) + 4 * n + (i & 3); }

struct GUnit { const char* a; const char* b; int pm, pn, nt, piece; };
struct GSched {
    const char* X; const char* W; int K, nM, nN, pn0, t0, t1, G, c, split;
    DI bool next(int i, GUnit& u) const {
        const long L = (long)i * G + c; const int nMf = split ? 32 : nM; const int nwg = nMf * nN;
        const size_t tstep = (size_t)BM * K * 2;
        if (L >= nwg) {
            if (!split) return false;
            const int idx = (int)(L - nwg); if (idx >= 256) return false;
            const int uu = idx >> 4, kp = idx & 15;
            u.pm = 32 + (uu >> 3); u.pn = uu & 7; u.nt = 4; u.piece = idx;
            u.a = X + (size_t)u.pm * tstep + (size_t)kp * 512; u.b = W + (size_t)u.pn * tstep + (size_t)kp * 512;
            return true;
        }
        int wgid = (int)L; { const int q = nwg / 8, r = nwg % 8, xcd = wgid % 8, off = wgid / 8; wgid = (xcd < r ? xcd * (q + 1) : r * (q + 1) + (xcd - r) * q) + off; }
        constexpr int WGM = 4;
        const int nig = WGM * nN, gid = wgid / nig, fm = gid * WGM, gsz = (nMf - fm) < WGM ? (nMf - fm) : WGM;
        u.pm = fm + ((wgid % nig) % gsz); u.pn = pn0 + (wgid % nig) / gsz; u.nt = K / BK; u.piece = -1;
        const char* xp = X + (size_t)u.pm * tstep; const char* wp = W + (size_t)u.pn * tstep;
        const bool tr = (u.pn >= t0) && (u.pn < t1);
        u.a = tr ? wp : xp; u.b = tr ? xp : wp;
        return true;
    }
};

template <class Epi>
DI void gemm_phase(LAS unsigned char* lds, const GSched& S, const Epi& E) {
    int tid = threadIdx.x; asm volatile("" : "+v"(tid));
    const int wid = __builtin_amdgcn_readfirstlane(tid >> 6), lane = tid & 63, wr = wid >> 2, wc = wid & 3, fr = lane & 15, fq = lane >> 4;
    const int K = S.K;
    unsigned voffA[2], voffB[2];
#pragma unroll
    for (int i = 0; i < 2; ++i) { int R, C; stage_rc(tid * 16 + i * 8192, R, C); const int Rb = (R & ~31) + perm32(R & 31);
        voffA[i] = (unsigned)(R * K + C) * 2u; voffB[i] = (unsigned)(Rb * K + C) * 2u; }
    const size_t kstep = (size_t)(BK * 2);
    const size_t hstep = (size_t)HALF * K * 2;
    const unsigned ldsw = (unsigned)wid * 1024u;
    const int aoff = lds_byte(wr * 64 + fr, fq * 8), boff = lds_byte(wc * 32 + fr, fq * 8);
#define PG8_SA(b, h) (((b) * 2 + (h)) * HTB)
#define PG8_SB(b, h) ((4 + (b) * 2 + (h)) * HTB)
#define PG8_STAGE(bufoff, gbase, voff) do { _Pragma("unroll") for (int _i = 0; _i < 2; ++_i) \
        __builtin_amdgcn_global_load_lds((const unsigned*)((const char*)(gbase) + (voff)[_i]), (LAS unsigned*)(lds + (bufoff) + ldsw + _i * 8192), 16, 0, 0); } while (0)
#define PG8_LDA(dst, b, h) do { _Pragma("unroll") for (int m = 0; m < 4; ++m) _Pragma("unroll") for (int k = 0; k < 2; ++k) dst[m][k] = *(const LAS bf16x8*)(lds + PG8_SA(b, h) + aoff + m * 2048 + k * 1024); } while (0)
#define PG8_LDB(dst, b, h) do { _Pragma("unroll") for (int n = 0; n < 2; ++n) _Pragma("unroll") for (int k = 0; k < 2; ++k) dst[n][k] = *(const LAS bf16x8*)(lds + PG8_SB(b, h) + boff + n * 2048 + k * 1024); } while (0)
#define PG8_MMA(ai, bj, At, Bt) do { __builtin_amdgcn_s_setprio(1); _Pragma("unroll") for (int m = 0; m < 4; ++m) _Pragma("unroll") for (int n = 0; n < 2; ++n) _Pragma("unroll") for (int k = 0; k < 2; ++k) \
        acc[ai][bj][m][n] = __builtin_amdgcn_mfma_f32_16x16x32_bf16(Bt[n][k], At[m][k], acc[ai][bj][m][n], 0, 0, 0); __builtin_amdgcn_s_setprio(0); } while (0)
#define PG8_WAIT_V(n) asm volatile("s_waitcnt vmcnt(" #n ")" ::: "memory")
#define PG8_WAIT_L(n) asm volatile("s_waitcnt lgkmcnt(" #n ")" ::: "memory")
#define PG8_BAR __builtin_amdgcn_s_barrier()
#define PG8_SCHED __builtin_amdgcn_sched_barrier(0)
    GUnit cur, nxt; int ui = 0;
    if (!S.next(0, cur)) return;
    f32x4 acc[2][2][4][2];
#pragma unroll
    for (int a = 0; a < 2; ++a)
#pragma unroll
        for (int b = 0; b < 2; ++b)
#pragma unroll
            for (int m = 0; m < 4; ++m)
#pragma unroll
                for (int n = 0; n < 2; ++n) acc[a][b][m][n] = (f32x4){0.f, 0.f, 0.f, 0.f};
    bf16x8 At[4][2], B0[2][2], B1[2][2];
    const char* cA = cur.a; const char* cB = cur.b;
    PG8_STAGE(PG8_SB(0, 0), cB, voffB); PG8_STAGE(PG8_SB(0, 1), cB + hstep, voffB); PG8_STAGE(PG8_SA(0, 0), cA, voffA); PG8_STAGE(PG8_SA(0, 1), cA + hstep, voffA);
    if (wr == 1) PG8_BAR;
    PG8_WAIT_V(2); PG8_BAR;
    PG8_STAGE(PG8_SB(1, 0), cB + kstep, voffB); PG8_STAGE(PG8_SA(1, 0), cA + kstep, voffA); PG8_STAGE(PG8_SB(1, 1), cB + hstep + kstep, voffB);
    PG8_WAIT_V(6); PG8_BAR;
    for (;;) {
        const bool has_next = S.next(ui + 1, nxt);
        const char* nA = has_next ? nxt.a : cA; const char* nB = has_next ? nxt.b : cB;
        const int nt = cur.nt;
        for (int t = 0; t < nt; t += 2) {
            const bool last = (t == nt - 2);
            const char* a1 = cA + (size_t)(t + 1) * kstep;
            const char* a2 = last ? nA : cA + (size_t)(t + 2) * kstep; const char* b2 = last ? nB : cB + (size_t)(t + 2) * kstep;
            const char* a3 = a2 + kstep; const char* b3 = b2 + kstep;
            PG8_LDB(B0, 0, 0); PG8_LDB(B1, 0, 1); PG8_SCHED; PG8_LDA(At, 0, 0); PG8_STAGE(PG8_SA(1, 1), a1 + hstep, voffA);
            PG8_WAIT_V(8); PG8_WAIT_L(0); PG8_BAR; PG8_MMA(0, 0, At, B0); PG8_MMA(0, 1, At, B1); PG8_BAR; PG8_SCHED;
            PG8_LDA(At, 0, 1); PG8_STAGE(PG8_SB(0, 0), b2, voffB); PG8_STAGE(PG8_SB(0, 1), b2 + hstep, voffB); PG8_STAGE(PG8_SA(0, 0), a2, voffA);
            PG8_WAIT_V(8); PG8_WAIT_L(0); PG8_BAR; PG8_MMA(1, 0, At, B0); PG8_MMA(1, 1, At, B1); PG8_BAR; PG8_SCHED;
            PG8_LDB(B0, 1, 0); PG8_LDB(B1, 1, 1); PG8_SCHED; PG8_LDA(At, 1, 0); PG8_STAGE(PG8_SA(0, 1), a2 + hstep, voffA);
            PG8_WAIT_V(8); PG8_WAIT_L(0); PG8_BAR; PG8_MMA(0, 0, At, B0); PG8_MMA(0, 1, At, B1); PG8_BAR; PG8_SCHED;
            PG8_LDA(At, 1, 1); PG8_STAGE(PG8_SB(1, 0), b3, voffB); PG8_STAGE(PG8_SB(1, 1), b3 + hstep, voffB); PG8_STAGE(PG8_SA(1, 0), a3, voffA);
            PG8_WAIT_V(8); PG8_WAIT_L(0); PG8_BAR; PG8_MMA(1, 0, At, B0); PG8_MMA(1, 1, At, B1); PG8_BAR; PG8_SCHED;
        }
        if (wr == 0) PG8_BAR;
        E(acc, cur, wr, wc, fr, fq);
        if (!has_next) break;
#pragma unroll
        for (int a = 0; a < 2; ++a)
#pragma unroll
            for (int b = 0; b < 2; ++b)
#pragma unroll
                for (int m = 0; m < 4; ++m)
#pragma unroll
                    for (int n = 0; n < 2; ++n) acc[a][b][m][n] = (f32x4){0.f, 0.f, 0.f, 0.f};
        cur = nxt; cA = nA; cB = nB; ++ui;
        if (wr == 1) PG8_BAR;
    }
    PG8_WAIT_V(0);
    PG8_BAR;
#undef PG8_SA
#undef PG8_SB
#undef PG8_STAGE
#undef PG8_LDA
#undef PG8_LDB
#undef PG8_MMA
#undef PG8_WAIT_V
#undef PG8_WAIT_L
#undef PG8_BAR
#undef PG8_SCHED
}

struct EpiHgrnIn {
    bf16_t* Qb; bf16_t* Kb; float* LF; bf16_t* VT; bf16_t* Gb; const float* lb; const float* SS; const float* onorm;
    DI void operator()(const f32x4 (&acc_in)[2][2][4][2], const GUnit& u, int wr, int wc, int fr, int fq) const {
        const int pn = u.pn;
        if (pn >= 32) {
            const int f0 = (pn - 32) * 256 + wr * 64 + fr, t0 = u.pm * 256 + wc * 32 + 8 * fq;
            f32x4 rt[2][2];
#pragma unroll
            for (int bj = 0; bj < 2; ++bj)
#pragma unroll
                for (int n = 0; n < 2; ++n) { const f32x4 s = *(const f32x4*)(SS + t0 + bj * 128 + 4 * n);
                    rt[bj][n] = (f32x4){__builtin_amdgcn_rsqf(s[0] * (1.f / D) + EPS), __builtin_amdgcn_rsqf(s[1] * (1.f / D) + EPS), __builtin_amdgcn_rsqf(s[2] * (1.f / D) + EPS), __builtin_amdgcn_rsqf(s[3] * (1.f / D) + EPS)}; }
#pragma unroll
            for (int ai = 0; ai < 2; ++ai)
#pragma unroll
                for (int m = 0; m < 4; ++m) { bf16_t* rowp = VT + (size_t)(f0 + ai * 128 + m * 16) * MP + t0;
#pragma unroll
                    for (int bj = 0; bj < 2; ++bj) { const f32x4 v0 = acc_in[ai][bj][m][0] * rt[bj][0], v1 = acc_in[ai][bj][m][1] * rt[bj][1];
                        u32x4 w = {pk2(v0[0], v0[1]), pk2(v0[2], v0[3]), pk2(v1[0], v1[1]), pk2(v1[2], v1[3])}; *(u32x4*)(rowp + bj * 128) = w; } }
            return;
        }
        const int row0 = u.pm * 256 + wr * 64 + fr;
        if (pn < 8) {
            const int col0 = pn * 256 + wc * 32 + 8 * fq; const float QS = 0.08838834764831845f;
#pragma unroll
            for (int ai = 0; ai < 2; ++ai)
#pragma unroll
                for (int m = 0; m < 4; ++m) { bf16_t* rowp = Qb + (size_t)(row0 + ai * 128 + m * 16) * D + col0;
                    const float rs = __builtin_amdgcn_rsqf(SS[row0 + ai * 128 + m * 16] * (1.f / D) + EPS);
#pragma unroll
                    for (int bj = 0; bj < 2; ++bj) { const f32x4 v0 = acc_in[ai][bj][m][0] * rs, v1 = acc_in[ai][bj][m][1] * rs;
                        u32x4 w = {pk2(fsilu(v0[0]) * QS, fsilu(v0[1]) * QS), pk2(fsilu(v0[2]) * QS, fsilu(v0[3]) * QS), pk2(fsilu(v1[0]) * QS, fsilu(v1[1]) * QS), pk2(fsilu(v1[2]) * QS, fsilu(v1[3]) * QS)};
                        *(u32x4*)(rowp + bj * 128) = w; } }
        } else if (pn < 16) {
            const int col0 = (pn - 8) * 256 + wc * 32 + 8 * fq;
#pragma unroll
            for (int bj = 0; bj < 2; ++bj) {
                const f32x4 l0 = *(const f32x4*)(lb + col0 + bj * 128), l1 = *(const f32x4*)(lb + col0 + bj * 128 + 4);
#pragma unroll
                for (int ai = 0; ai < 2; ++ai)
#pragma unroll
                    for (int m = 0; m < 4; ++m) { const size_t ro = (size_t)(row0 + ai * 128 + m * 16) * D + col0 + bj * 128;
                        const float rs = __builtin_amdgcn_rsqf(SS[row0 + ai * 128 + m * 16] * (1.f / D) + EPS);
                        f32x4 lf0, lf1; float kk[8];
#pragma unroll
                        for (int e = 0; e < 8; ++e) { float f = (e < 4 ? acc_in[ai][bj][m][0][e & 3] : acc_in[ai][bj][m][1][e & 3]) * rs; const float lbv = e < 4 ? l0[e & 3] : l1[e & 3];
                            f = fminf(fmaxf(f, -80.f), 80.f);
                            const float ex = __expf(-f), sig = __builtin_amdgcn_rcpf(1.f + ex), om = 1.f - lbv;
                            const float lg = __log2f(lbv + om * sig); kk[e] = om * ex * sig;
                            if (e < 4) lf0[e & 3] = lg; else lf1[e & 3] = lg; }
                        *(f32x4*)(LF + ro) = lf0; *(f32x4*)(LF + ro + 4) = lf1;
                        u32x4 w = {pk2(kk[0], kk[1]), pk2(kk[2], kk[3]), pk2(kk[4], kk[5]), pk2(kk[6], kk[7])}; *(u32x4*)(Kb + ro) = w; }
            }
        } else {
            const int col0 = (pn - 16) * 256 + wc * 32 + 8 * fq;
            f32x4 on[2][2];
#pragma unroll
            for (int bj = 0; bj < 2; ++bj) { on[bj][0] = *(const f32x4*)(onorm + wc * 32 + 8 * fq + bj * 128); on[bj][1] = *(const f32x4*)(onorm + wc * 32 + 8 * fq + bj * 128 + 4); }
#pragma unroll
            for (int ai = 0; ai < 2; ++ai)
#pragma unroll
                for (int m = 0; m < 4; ++m) { bf16_t* rowp = Gb + (size_t)(row0 + ai * 128 + m * 16) * EW + col0;
                    const float rs = __builtin_amdgcn_rsqf(SS[row0 + ai * 128 + m * 16] * (1.f / D) + EPS);
#pragma unroll
                    for (int bj = 0; bj < 2; ++bj) { const f32x4 v0 = acc_in[ai][bj][m][0] * rs, v1 = acc_in[ai][bj][m][1] * rs; const f32x4 n0 = on[bj][0], n1 = on[bj][1];
                        u32x4 w = {pk2(fsilu(v0[0]) * n0[0], fsilu(v0[1]) * n0[1]), pk2(fsilu(v0[2]) * n0[2], fsilu(v0[3]) * n0[3]), pk2(fsilu(v1[0]) * n1[0], fsilu(v1[1]) * n1[1]), pk2(fsilu(v1[2]) * n1[2], fsilu(v1[3]) * n1[3])};
                        *(u32x4*)(rowp + bj * 128) = w; } }
        }
    }
};

struct EpiOut {
    float* X; bf16_t* XB; float* SS; float* P;
    DI void operator()(const f32x4 (&acc)[2][2][4][2], const GUnit& u, int wr, int wc, int fr, int fq) const {
        if (u.piece >= 0) {
            float* pb = P + (size_t)u.piece * 65536 + (wr * 64 + fr) * 256 + wc * 32 + 8 * fq;
#pragma unroll
            for (int ai = 0; ai < 2; ++ai)
#pragma unroll
                for (int m = 0; m < 4; ++m)
#pragma unroll
                    for (int bj = 0; bj < 2; ++bj) { f32x4* q = (f32x4*)(pb + (ai * 128 + m * 16) * 256 + bj * 128); q[0] = acc[ai][bj][m][0]; q[1] = acc[ai][bj][m][1]; }
            return;
        }
        const int row0 = u.pm * 256 + wr * 64 + fr, col0 = u.pn * 256 + wc * 32 + 8 * fq;
#pragma unroll
        for (int ai = 0; ai < 2; ++ai)
#pragma unroll
            for (int m = 0; m < 4; ++m) { const int row = row0 + ai * 128 + m * 16; float* rowp = X + (size_t)row * D + col0; bf16_t* bp = XB + (size_t)row * D + col0; float ss = 0.f;
#pragma unroll
                for (int bj = 0; bj < 2; ++bj) { f32x4* p = (f32x4*)(rowp + bj * 128); const f32x4 x0 = p[0] + acc[ai][bj][m][0], x1 = p[1] + acc[ai][bj][m][1]; p[0] = x0; p[1] = x1;
                    u32x4 w = {pk2(x0[0], x0[1]), pk2(x0[2], x0[3]), pk2(x1[0], x1[1]), pk2(x1[2], x1[3])}; *(u32x4*)(bp + bj * 128) = w;
                    ss += (x0[0] * x0[0] + x0[1] * x0[1]) + (x0[2] * x0[2] + x0[3] * x0[3]) + (x1[0] * x1[0] + x1[1] * x1[1]) + (x1[2] * x1[2] + x1[3] * x1[3]); }
                ss += __shfl_xor(ss, 16); ss += __shfl_xor(ss, 32);
                if (fq == 0) __hip_atomic_fetch_add(SS + row, ss, __ATOMIC_RELAXED, __HIP_MEMORY_SCOPE_AGENT); }
    }
};

struct EpiSwaIn {
    bf16_t* KS; bf16_t* VTS; bf16_t* QA; bf16_t* GA; const float* SS;
    DI void operator()(const f32x4 (&acc)[2][2][4][2], const GUnit& u, int wr, int wc, int fr, int fq) const {
        const int pn = u.pn;
        const bool tr = (pn == 2 || pn == 3);
        bf16_t* base; int ld, r0, c0; int act;
        if (tr) { base = VTS; ld = MP; r0 = (pn - 2) * 256; c0 = u.pm * 256; act = 0; }
        else if (pn < 2) { base = KS; ld = 512; r0 = u.pm * 256; c0 = pn * 256; act = 0; }
        else if (pn < 20) { base = QA; ld = EW; r0 = u.pm * 256; c0 = (pn - 4) * 256; act = 1; }
        else { base = GA; ld = EW; r0 = u.pm * 256; c0 = (pn - 20) * 256; act = 2; }
        const int row0 = r0 + wr * 64 + fr, col0 = c0 + wc * 32 + 8 * fq;
        f32x4 rt[2][2];
#pragma unroll
        for (int bj = 0; bj < 2; ++bj)
#pragma unroll
            for (int n = 0; n < 2; ++n) { rt[bj][n] = (f32x4){1.f, 1.f, 1.f, 1.f};
                if (tr) { const f32x4 s = *(const f32x4*)(SS + col0 + bj * 128 + 4 * n);
                    rt[bj][n] = (f32x4){__builtin_amdgcn_rsqf(s[0] * (1.f / D) + EPS), __builtin_amdgcn_rsqf(s[1] * (1.f / D) + EPS), __builtin_amdgcn_rsqf(s[2] * (1.f / D) + EPS), __builtin_amdgcn_rsqf(s[3] * (1.f / D) + EPS)}; } }
#pragma unroll
        for (int ai = 0; ai < 2; ++ai)
#pragma unroll
            for (int m = 0; m < 4; ++m) { bf16_t* rowp = base + (size_t)(row0 + ai * 128 + m * 16) * ld + col0;
                const float rs = tr ? 1.f : __builtin_amdgcn_rsqf(SS[row0 + ai * 128 + m * 16] * (1.f / D) + EPS);
#pragma unroll
                for (int bj = 0; bj < 2; ++bj) { f32x4 v0 = acc[ai][bj][m][0] * rt[bj][0] * rs, v1 = acc[ai][bj][m][1] * rt[bj][1] * rs;
                    if (act == 1) { v0 = v0 * 0.18033688011112042f; v1 = v1 * 0.18033688011112042f; }
                    else if (act == 2) { v0 = (f32x4){fsilu(v0[0]), fsilu(v0[1]), fsilu(v0[2]), fsilu(v0[3])}; v1 = (f32x4){fsilu(v1[0]), fsilu(v1[1]), fsilu(v1[2]), fsilu(v1[3])}; }
                    u32x4 w = {pk2(v0[0], v0[1]), pk2(v0[2], v0[3]), pk2(v1[0], v1[1]), pk2(v1[2], v1[3])}; *(u32x4*)(rowp + bj * 128) = w; } }
    }
};

DI void tr_load(const float* W, int N, int nblk, int item, int lane, f32x4 (&v)[8]) {
    const int kb = item / nblk, nb = item - kb * nblk, k0 = 64 * kb, n0 = 32 * nb, lr = lane >> 3, lc = (lane & 7) * 4;
#pragma unroll
    for (int i = 0; i < 8; ++i) v[i] = __builtin_nontemporal_load((const f32x4*)(W + (size_t)(k0 + 8 * i + lr) * N + n0 + lc));
}
DI void tr_store(const f32x4 (&v)[8], int K, int nblk, const float* gain, bf16_t* WT, int mapkind, LAS float* scr, int item, int lane) {
    const int kb = item / nblk, nb = item - kb * nblk, k0 = 64 * kb, n0 = 32 * nb, lr = lane >> 3, lc = (lane & 7) * 4;
    int r0 = n0;
    if (mapkind == 1) r0 = n0 < 4096 ? n0 : (n0 < 8192 ? n0 + 4096 : n0 - 4096);
#pragma unroll
    for (int i = 0; i < 8; ++i) { const float gv = gain ? gain[k0 + 8 * i + lr] : 1.f; LAS float* d = scr + (8 * i + lr) * 33 + lc; d[0] = v[i].x * gv; d[1] = v[i].y * gv; d[2] = v[i].z * gv; d[3] = v[i].w * gv; }
    asm volatile("s_waitcnt lgkmcnt(0)" ::: "memory");
    const int c = lane & 7;
#pragma unroll
    for (int j = 0; j < 4; ++j) { const int n = (lane >> 3) + 8 * j; const LAS float* s = scr + (8 * c) * 33 + n;
        u32x4 o; o.x = pk2(s[0 * 33], s[1 * 33]); o.y = pk2(s[2 * 33], s[3 * 33]); o.z = pk2(s[4 * 33], s[5 * 33]); o.w = pk2(s[6 * 33], s[7 * 33]);
        *(u32x4*)(WT + (size_t)(r0 + n) * K + k0 + 8 * c) = o; }
    asm volatile("s_waitcnt lgkmcnt(0)" ::: "memory");
}
DI void convert_matrix(LAS unsigned char* lds, const Params& p, int id, int wslot, int nslots, int lane, int wave) {
    const float* W; const float* gain = nullptr; bf16_t* WT; int K, N, mapkind = 0;
    unsigned char* ws = p.ws;
    if (id < 2) { W = p.in[7] + (size_t)id * D * 12288; gain = p.in[6] + id * D; WT = (bf16_t*)(ws + OFF_WIN_A) + (size_t)id * 12288 * D; K = D; N = 12288; mapkind = 1; }
    else if (id < 4) { W = p.in[10] + (size_t)(id - 2) * EW * D; WT = (bf16_t*)(ws + OFF_WOUT_A) + (size_t)(id - 2) * D * EW; K = EW; N = D; }
    else if (id == 4) { W = p.in[12]; gain = p.in[11]; WT = (bf16_t*)(ws + OFF_WKV); K = D; N = 1024; }
    else if (id < 7) { W = p.in[14] + (size_t)(id - 5) * D * 8192; gain = p.in[13] + (id - 5) * D; WT = (bf16_t*)(ws + OFF_WIN_B) + (size_t)(id - 5) * 8192 * D; K = D; N = 8192; }
    else { W = p.in[16] + (size_t)(id - 7) * EW * D; WT = (bf16_t*)(ws + OFF_WOUT_B) + (size_t)(id - 7) * D * EW; K = EW; N = D; }
    const int nitems = (K / 64) * (N / 32);
    LAS float* scr = (LAS float*)(lds + wave * 8448);
    const int nblk = N / 32;
    f32x4 va[8], vb[8];
    int it = wslot;
    if (it < nitems) tr_load(W, N, nblk, it, lane, va);
    while (it < nitems) {
        const int it2 = it + nslots;
        if (it2 < nitems) tr_load(W, N, nblk, it2, lane, vb);
        tr_store(va, K, nblk, gain, WT, mapkind, scr, it, lane);
        if (it2 >= nitems) break;
        const int it3 = it2 + nslots;
        if (it3 < nitems) tr_load(W, N, nblk, it3, lane, va);
        tr_store(vb, K, nblk, gain, WT, mapkind, scr, it2, lane);
        it = it3;
    }
}
DI void convert_set(LAS unsigned char* lds, const Params& p, int set, int wslot, int nslots, int lane, int wave) {
    if (set == 0) convert_matrix(lds, p, 0, wslot, nslots, lane, wave);
    else if (set == 1) { convert_matrix(lds, p, 2, wslot, nslots, lane, wave); convert_matrix(lds, p, 3, wslot, nslots, lane, wave); convert_matrix(lds, p, 1, wslot, nslots, lane, wave); }
    else { for (int id = 4; id < 9; ++id) convert_matrix(lds, p, id, wslot, nslots, lane, wave); }
}

DI void norm_row(const float* src, float* xcopy, bf16_t* xb, float* y, const float* gain, int lane, float* ssout = nullptr) {
    const f32x4* xr = (const f32x4*)src + lane;
    f32x4 v[8]; float s = 0.f;
#pragma unroll
    for (int j = 0; j < 8; ++j) { v[j] = xr[64 * j]; s += (v[j].x * v[j].x + v[j].y * v[j].y) + (v[j].z * v[j].z + v[j].w * v[j].w); }
    const float tot = wave_sum(s);
    float rstd = __builtin_amdgcn_rsqf(tot * (1.f / D) + EPS);
    if (ssout) { if (lane == 0) *ssout = tot; rstd = 1.f; }
    if (xcopy) { f32x4* xc = (f32x4*)xcopy + lane;
#pragma unroll
        for (int j = 0; j < 8; ++j) xc[64 * j] = v[j]; }
    if (xb) { u32x2* o = (u32x2*)xb + lane;
#pragma unroll
        for (int j = 0; j < 8; ++j) { u32x2 w = {pk2(v[j].x * rstd, v[j].y * rstd), pk2(v[j].z * rstd, v[j].w * rstd)}; o[64 * j] = w; } }
    if (y) { f32x4* o = (f32x4*)y + lane; const f32x4* gr = (const f32x4*)gain + lane;
#pragma unroll
        for (int j = 0; j < 8; ++j) { const f32x4 gg = gr[64 * j]; o[64 * j] = v[j] * rstd * gg; } }
}

constexpr int S2_PBUF = 27648, S2_KE = 8448, S2_KET = 16896, S2_EL = 27136;
constexpr int S2_V = 55296, S2_OT = 88064, S2_ON = 154624;
DI void scan_phase(LAS unsigned char* lds, const Params& p, int layer, bool do_conv, const bf16_t* Qb, const bf16_t* Kb, const float* LF, const bf16_t* VT, const bf16_t* Gb, bf16_t* OG) {
    int tid = threadIdx.x; asm volatile("" : "+v"(tid));
    const int lane = tid & 63, w = __builtin_amdgcn_readfirstlane(tid >> 6), c = lane & 15, g = lane >> 4;
    const int G = gridDim.x, bid = blockIdx.x;
    int first, stride;
    if (G >= 128) { if (bid < 64) { first = bid; stride = 1 << 20; } else { first = 64 + (bid - 64); stride = G - 64; } } else { first = bid; stride = G; }
    if (tid < 256) ((LAS float*)(lds + S2_ON))[tid] = p.in[9][layer * 256 + tid];
    if (w < 4) {
    for (int item = first; item < 576; item += stride) {
        const bool isP = item < 64;
        int b, h, rowbase, ntok;
        if (isP) { b = item >> 4; h = item & 15; rowbase = b * TP; ntok = TP; } else { const int s = item - 64; b = s >> 4; h = s & 15; rowbase = NPR + b * 8; ntok = 8; }
        const int nsteps = (ntok + 31) >> 5;
            const int cw = w;
            f32x4 S[8][4];
            if (isP) {
#pragma unroll
                for (int i = 0; i < 8; ++i)
#pragma unroll
                    for (int dvt = 0; dvt < 4; ++dvt) S[i][dvt] = (f32x4){0.f, 0.f, 0.f, 0.f};
            } else {
                const float* sp = p.in[2] + (size_t)((layer * 32 + b) * 16 + h) * 32768 + 64 * cw + c;
#pragma unroll
                for (int i = 0; i < 8; ++i)
#pragma unroll
                    for (int dvt = 0; dvt < 4; ++dvt)
#pragma unroll
                        for (int j = 0; j < 4; ++j) S[i][dvt][j] = sp[(size_t)(16 * i + 4 * g + j) * 256 + 16 * dvt];
            }
            const int niter = (nsteps + 3) & ~1;
            for (int it = 0; it < niter; ++it) {
                if (it >= 1 && it <= nsteps) {
                    const int par = (it - 1) & 1;
                    LAS unsigned char* pbuf = lds + par * S2_PBUF;
                    LAS unsigned char* vbuf = lds + S2_V + par * 16384;
                    LAS float* OT = (LAS float*)(lds + S2_OT + par * 33280);
                    const int swz = (c >> 2) & 3;
                    f32x4 a00 = {0.f, 0.f, 0.f, 0.f}, a01 = a00, a11 = a00;
#pragma unroll
                    for (int kk = 0; kk < 4; ++kk) {
                        bf16x8 qe[2], ke[2];
#pragma unroll
                        for (int mt = 0; mt < 2; ++mt) {
                            const int off = (16 * mt + c) * 264 + (32 * kk + 4 * g) * 2;
                            const u32x2 q0 = *(const LAS u32x2*)(pbuf + off), q1 = *(const LAS u32x2*)(pbuf + off + 32);
                            const u32x2 k0 = *(const LAS u32x2*)(pbuf + S2_KE + off), k1 = *(const LAS u32x2*)(pbuf + S2_KE + off + 32);
                            qe[mt] = __builtin_bit_cast(bf16x8, (u32x4){q0.x, q0.y, q1.x, q1.y});
                            ke[mt] = __builtin_bit_cast(bf16x8, (u32x4){k0.x, k0.y, k1.x, k1.y});
                        }
                        a00 = __builtin_amdgcn_mfma_f32_16x16x32_bf16(ke[0], qe[0], a00, 0, 0, 0);
                        a01 = __builtin_amdgcn_mfma_f32_16x16x32_bf16(ke[0], qe[1], a01, 0, 0, 0);
                        a11 = __builtin_amdgcn_mfma_f32_16x16x32_bf16(ke[1], qe[1], a11, 0, 0, 0);
                    }
#pragma unroll
                    for (int j = 0; j < 4; ++j) { const bool keep = (4 * g + j) <= c; a00[j] = keep ? a00[j] : 0.f; a11[j] = keep ? a11[j] : 0.f; }
                    const bf16x8 pa0 = __builtin_bit_cast(bf16x8, (u32x4){pk2(a00[0], a00[1]), pk2(a00[2], a00[3]), 0u, 0u});
                    const bf16x8 pa1 = __builtin_bit_cast(bf16x8, (u32x4){pk2(a01[0], a01[1]), pk2(a01[2], a01[3]), pk2(a11[0], a11[1]), pk2(a11[2], a11[3])});
                    __builtin_amdgcn_sched_barrier(0);
#pragma unroll
                    for (int dh = 0; dh < 2; ++dh) {
                        bf16x8 vreg[2];
#pragma unroll
                        for (int d = 0; d < 2; ++d) {
                            const int row = 64 * cw + 16 * (2 * dh + d) + c;
                            const u32x2 a = *(const LAS u32x2*)(vbuf + row * 64 + ((g ^ swz) * 8)), bq = *(const LAS u32x2*)(vbuf + row * 64 + (((4 + g) ^ swz) * 8));
                            vreg[d] = __builtin_bit_cast(bf16x8, (u32x4){a.x, a.y, bq.x, bq.y});
                        }
                        f32x4 o[2][2];
#pragma unroll
                        for (int mt = 0; mt < 2; ++mt) { o[mt][0] = (f32x4){0.f, 0.f, 0.f, 0.f}; o[mt][1] = (f32x4){0.f, 0.f, 0.f, 0.f}; }
#pragma unroll
                        for (int kk = 0; kk < 4; ++kk) {
                            bf16x8 qe[2];
#pragma unroll
                            for (int mt = 0; mt < 2; ++mt) {
                                const int off = (16 * mt + c) * 264 + (32 * kk + 4 * g) * 2;
                                const u32x2 q0 = *(const LAS u32x2*)(pbuf + off), q1 = *(const LAS u32x2*)(pbuf + off + 32);
                                qe[mt] = __builtin_bit_cast(bf16x8, (u32x4){q0.x, q0.y, q1.x, q1.y});
                            }
#pragma unroll
                            for (int d = 0; d < 2; ++d) {
                                const f32x4 s0 = S[2 * kk][2 * dh + d], s1 = S[2 * kk + 1][2 * dh + d];
                                const bf16x8 sb = __builtin_bit_cast(bf16x8, (u32x4){pk2(s0[0], s0[1]), pk2(s0[2], s0[3]), pk2(s1[0], s1[1]), pk2(s1[2], s1[3])});
                                o[0][d] = __builtin_amdgcn_mfma_f32_16x16x32_bf16(qe[0], sb, o[0][d], 0, 0, 0);
                                o[1][d] = __builtin_amdgcn_mfma_f32_16x16x32_bf16(qe[1], sb, o[1][d], 0, 0, 0);
                            }
                        }
#pragma unroll
                        for (int d = 0; d < 2; ++d) {
                            o[0][d] = __builtin_amdgcn_mfma_f32_16x16x32_bf16(pa0, vreg[d], o[0][d], 0, 0, 0);
                            o[1][d] = __builtin_amdgcn_mfma_f32_16x16x32_bf16(pa1, vreg[d], o[1][d], 0, 0, 0);
                        }
#pragma unroll
                        for (int i = 0; i < 8; ++i) {
                            const u32x2 t0 = *(const LAS u32x2*)(pbuf + S2_KET + (16 * i + c) * 80 + 8 * g), t1 = *(const LAS u32x2*)(pbuf + S2_KET + (16 * i + c) * 80 + 32 + 8 * g);
                            const bf16x8 kt = __builtin_bit_cast(bf16x8, (u32x4){t0.x, t0.y, t1.x, t1.y});
                            const f32x4 el = *(const LAS f32x4*)(pbuf + S2_EL + (16 * i + 4 * g) * 4);
#pragma unroll
                            for (int d = 0; d < 2; ++d) { S[i][2 * dh + d] = __builtin_amdgcn_mfma_f32_16x16x32_bf16(kt, vreg[d], S[i][2 * dh + d], 0, 0, 0); S[i][2 * dh + d] = S[i][2 * dh + d] * el; }
                        }
#pragma unroll
                        for (int mt = 0; mt < 2; ++mt)
#pragma unroll
                            for (int d = 0; d < 2; ++d)
#pragma unroll
                                for (int j = 0; j < 4; ++j) OT[(16 * mt + 4 * g + j) * 260 + 64 * cw + 16 * (2 * dh + d) + c] = o[mt][d][j];
                        __builtin_amdgcn_sched_barrier(0);
                    }
                }
                lds_barrier();
            }
            {
                float* sp = p.out + (isP ? O_SP + (size_t)((layer * 4 + b) * 16 + h) * 32768 : O_SS + (size_t)((layer * 32 + b) * 16 + h) * 32768) + 64 * cw + c;
#pragma unroll
                for (int i = 0; i < 8; ++i)
#pragma unroll
                    for (int dvt = 0; dvt < 4; ++dvt)
#pragma unroll
                        for (int j = 0; j < 4; ++j) sp[(size_t)(16 * i + 4 * g + j) * 256 + 16 * dvt] = S[i][dvt][j];
            }
    }
    } else {
    for (int item = first; item < 576; item += stride) {
        const bool isP = item < 64;
        int b, h, rowbase, ntok;
        if (isP) { b = item >> 4; h = item & 15; rowbase = b * TP; ntok = TP; } else { const int s = item - 64; b = s >> 4; h = s & 15; rowbase = NPR + b * 8; ntok = 8; }
        const int nsteps = (ntok + 31) >> 5;
            const int pw = w - 4, pt = tid - 256;
            const int ch0 = 2 * (16 * pw + c), tg = g;
            const int ntk = pt >> 3, nsg = pt & 7;
            f32x2 Rlf[2][8]; unsigned Rq[2][8], Rk[2][8]; u32x4 Rv[2][4]; u32x2 Rg[2][8];
            const int niter = (nsteps + 3) & ~1;
#pragma unroll
            for (int hf = 0; hf < 2; ++hf) {
                const int pc = hf < nsteps - 1 ? hf : nsteps - 1;
                const size_t o = (size_t)(rowbase + 32 * pc + 8 * tg) * D + h * 128 + ch0;
#pragma unroll
                for (int i = 0; i < 8; ++i) { Rlf[hf][i] = *(const f32x2*)(LF + o + (size_t)i * D); Rq[hf][i] = *(const unsigned*)(Qb + o + (size_t)i * D); Rk[hf][i] = *(const unsigned*)(Kb + o + (size_t)i * D); }
                const bf16_t* vp = VT + (size_t)(h * 256 + pt) * MP + rowbase + 32 * pc;
#pragma unroll
                for (int q = 0; q < 4; ++q) Rv[hf][q] = *(const u32x4*)(vp + 8 * q);
#pragma unroll
                for (int e = 0; e < 8; ++e) Rg[hf][e] = (u32x2){0u, 0u};
            }
            for (int it0 = 0; it0 < niter; it0 += 2) {
#pragma unroll
                for (int hf = 0; hf < 2; ++hf) {
                    const int it = it0 + hf;
                    {
                        const int pc = it < nsteps - 1 ? it : nsteps - 1;
                        const int tok0 = 32 * pc, nvalid = (ntok - tok0) < 32 ? (ntok - tok0) : 32;
                        LAS unsigned char* pbuf = lds + hf * S2_PBUF;
                        LAS unsigned char* vbuf = lds + S2_V + hf * 16384;
                        {
                            const int nc = it >= 2 ? it - 2 : 0;
                            const int ntok0 = 32 * nc; int nvn = (ntok - ntok0) < 32 ? (ntok - ntok0) : 32; if (it < 2 || nc >= nsteps) nvn = 0;
                            const LAS float* OT = (const LAS float*)(lds + S2_OT + hf * 33280);
                            f32x4 ov[8]; float ss = 0.f;
#pragma unroll
                            for (int e = 0; e < 8; ++e) { ov[e] = *(const LAS f32x4*)(OT + ntk * 260 + 4 * nsg + 32 * e); ss += (ov[e].x * ov[e].x + ov[e].y * ov[e].y) + (ov[e].z * ov[e].z + ov[e].w * ov[e].w); }
                            ss += __shfl_xor(ss, 1); ss += __shfl_xor(ss, 2); ss += __shfl_xor(ss, 4);
                            const float rstd = __builtin_amdgcn_rsqf(ss * (1.f / 256.f) + EPS);
                            const int orow = ntk < nvn ? rowbase + ntok0 + ntk : MT + ntk;
                            const size_t ro = (size_t)orow * EW + h * 256 + 4 * nsg;
#pragma unroll
                            for (int e = 0; e < 8; ++e) {
                                const u32x2 gg = Rg[hf][e];
                                u32x2 wv = {pk2(ov[e].x * rstd * bflo(gg.x), ov[e].y * rstd * bfhi(gg.x)), pk2(ov[e].z * rstd * bflo(gg.y), ov[e].w * rstd * bfhi(gg.y))};
                                *(u32x2*)(OG + ro + 32 * e) = wv;
                            }
                        }
                        {
                            const size_t ro = (size_t)(rowbase + tok0 + ntk) * EW + h * 256 + 4 * nsg;
#pragma unroll
                            for (int e = 0; e < 8; ++e) Rg[hf][e] = *(const u32x2*)(Gb + ro + 32 * e);
                        }
                        float cs[8][2], kv[8][2], qv[8][2]; float r0 = 0.f, r1 = 0.f;
                        if (nvalid >= 32) {
#pragma unroll
                            for (int i = 0; i < 8; ++i) { r0 += Rlf[hf][i].x; r1 += Rlf[hf][i].y; cs[i][0] = r0; cs[i][1] = r1; kv[i][0] = bflo(Rk[hf][i]); kv[i][1] = bfhi(Rk[hf][i]); }
                        } else {
#pragma unroll
                            for (int i = 0; i < 8; ++i) { const bool ok = (8 * tg + i) < nvalid; r0 += ok ? Rlf[hf][i].x : 0.f; r1 += ok ? Rlf[hf][i].y : 0.f; cs[i][0] = r0; cs[i][1] = r1;
                                kv[i][0] = ok ? bflo(Rk[hf][i]) : 0.f; kv[i][1] = ok ? bfhi(Rk[hf][i]) : 0.f; }
                        }
#pragma unroll
                        for (int i = 0; i < 8; ++i) { qv[i][0] = bflo(Rq[hf][i]); qv[i][1] = bfhi(Rq[hf][i]); }
                        {
                            const int swz = (pt >> 2) & 3;
#pragma unroll
                            for (int q = 0; q < 4; ++q) {
                                const u32x4 v = Rv[hf][q];
                                *(LAS u32x2*)(vbuf + pt * 64 + (((2 * q) ^ swz) * 8)) = (u32x2){v.x, v.y};
                                *(LAS u32x2*)(vbuf + pt * 64 + (((2 * q + 1) ^ swz) * 8)) = (u32x2){v.z, v.w};
                            }
                        }
                        {
                            const int nc2 = (it + 2) < nsteps - 1 ? (it + 2) : nsteps - 1;
                            const size_t o = (size_t)(rowbase + 32 * nc2 + 8 * tg) * D + h * 128 + ch0;
#pragma unroll
                            for (int i = 0; i < 8; ++i) { Rlf[hf][i] = *(const f32x2*)(LF + o + (size_t)i * D); Rq[hf][i] = *(const unsigned*)(Qb + o + (size_t)i * D); Rk[hf][i] = *(const unsigned*)(Kb + o + (size_t)i * D); }
                            const bf16_t* vp = VT + (size_t)(h * 256 + pt) * MP + rowbase + 32 * nc2;
#pragma unroll
                            for (int q = 0; q < 4; ++q) Rv[hf][q] = *(const u32x4*)(vp + 8 * q);
                        }
                        float i0 = r0, i1 = r1;
                        { const float t0 = __shfl_up(i0, 16), t1 = __shfl_up(i1, 16); if (tg >= 1) { i0 += t0; i1 += t1; } }
                        { const float t0 = __shfl_up(i0, 32), t1 = __shfl_up(i1, 32); if (tg >= 2) { i0 += t0; i1 += t1; } }
                        const float last0 = __shfl(i0, 48 + c), last1 = __shfl(i1, 48 + c);
                        const float e0 = i0 - r0, e1 = i1 - r1;
                        unsigned ka[8];
#pragma unroll
                        for (int i = 0; i < 8; ++i) {
                            const float c0 = e0 + cs[i][0], c1 = e1 + cs[i][1];
                            const unsigned qp = pk2(qv[i][0] * __builtin_amdgcn_exp2f(c0), qv[i][1] * __builtin_amdgcn_exp2f(c1));
                            const unsigned kp = pk2(kv[i][0] * __builtin_amdgcn_exp2f(-c0), kv[i][1] * __builtin_amdgcn_exp2f(-c1));
                            *(LAS unsigned*)(pbuf + (8 * tg + i) * 264 + ch0 * 2) = qp;
                            *(LAS unsigned*)(pbuf + S2_KE + (8 * tg + i) * 264 + ch0 * 2) = kp;
                            ka[i] = kp;
                        }
                        *(LAS u32x4*)(pbuf + S2_KET + ch0 * 80 + 16 * tg) = (u32x4){__builtin_amdgcn_perm(ka[1], ka[0], 0x05040100u), __builtin_amdgcn_perm(ka[3], ka[2], 0x05040100u), __builtin_amdgcn_perm(ka[5], ka[4], 0x05040100u), __builtin_amdgcn_perm(ka[7], ka[6], 0x05040100u)};
                        *(LAS u32x4*)(pbuf + S2_KET + (ch0 + 1) * 80 + 16 * tg) = (u32x4){__builtin_amdgcn_perm(ka[1], ka[0], 0x07060302u), __builtin_amdgcn_perm(ka[3], ka[2], 0x07060302u), __builtin_amdgcn_perm(ka[5], ka[4], 0x07060302u), __builtin_amdgcn_perm(ka[7], ka[6], 0x07060302u)};
                        if (tg == 0) { *(LAS float*)(pbuf + S2_EL + ch0 * 4) = __builtin_amdgcn_exp2f(last0); *(LAS float*)(pbuf + S2_EL + ch0 * 4 + 4) = __builtin_amdgcn_exp2f(last1); }
                        lds_barrier();
                    }
                }
            }
    }
    }
    {
        int wslot = -1, nslots = 0;
        if (G >= 128) { if (bid >= 64) { wslot = (bid - 64) * 8 + w; nslots = (G - 64) * 8; } } else { wslot = bid * 8 + w; nslots = G * 8; }
        if (wslot >= 0 && do_conv) { __syncthreads(); convert_set(lds, p, layer + 1, wslot, nslots, lane, w); }
    }
}

constexpr int AT_K = 0, AT_V = 23040;
template <bool PRE>
DI void attn_compute(LAS unsigned char* lds, const bf16_t* QA, const bf16_t* GA, bf16_t* OA, bool isP, int t0, int qrowbase, int hh, float slope, float sink, int c, int g,
                     const bf16x8 (&qpre)[2][2], const u32x2 (&gpre)[2][4]) {
#pragma unroll
    for (int qt = 0; qt < 2; ++qt) {
        bf16x8 qf[2];
#pragma unroll
        for (int kk = 0; kk < 2; ++kk) qf[kk] = PRE ? qpre[qt][kk] : *(const bf16x8*)(QA + (size_t)(qrowbase + 16 * qt + c) * EW + hh * 64 + 32 * kk + 8 * g);
        f32x4 sT[10];
#pragma unroll
        for (int kt = 0; kt < 10; ++kt) {
            if (kt == (qt == 0 ? 9 : 0)) { sT[kt] = (f32x4){0.f, 0.f, 0.f, 0.f}; continue; }
            const bf16x8 k0 = *(const LAS bf16x8*)(lds + AT_K + (16 * kt + c) * 144 + 16 * g), k1 = *(const LAS bf16x8*)(lds + AT_K + (16 * kt + c) * 144 + 64 + 16 * g);
            f32x4 a = {0.f, 0.f, 0.f, 0.f};
            a = __builtin_amdgcn_mfma_f32_16x16x32_bf16(k0, qf[0], a, 0, 0, 0); a = __builtin_amdgcn_mfma_f32_16x16x32_bf16(k1, qf[1], a, 0, 0, 0); sT[kt] = a;
            if (kt & 1) __builtin_amdgcn_sched_barrier(0);
        }
        float m = -1e30f;
        const int dbase = 128 + 16 * qt + c - 4 * g;
        const int kmin = isP ? (128 - t0 - 4 * g) : -1000;
        const float sb = slope * (float)dbase;
        if (!isP || t0 >= 128) {
#pragma unroll
            for (int kt = 0; kt < 10; ++kt) {
                if (kt == (qt == 0 ? 9 : 0)) continue;
                const bool inner = (kt >= 1 + qt) && (kt <= 7 + qt);
#pragma unroll
                for (int j = 0; j < 4; ++j) { const int cst = 16 * kt + j; const int dist = dbase - cst;
                    const bool valid = inner ? true : ((unsigned)dist < 128u);
                    const float x = valid ? (sT[kt][j] - sb) + slope * (float)cst : -1e30f; sT[kt][j] = x; m = fmaxf(m, x); }
            }
        } else {
#pragma unroll
            for (int kt = 0; kt < 10; ++kt) {
                if (kt == (qt == 0 ? 9 : 0)) continue;
#pragma unroll
                for (int j = 0; j < 4; ++j) { const int cst = 16 * kt + j; const int dist = dbase - cst;
                    const bool valid = ((unsigned)dist < 128u) && (cst >= kmin);
                    const float x = valid ? (sT[kt][j] - sb) + slope * (float)cst : -1e30f; sT[kt][j] = x; m = fmaxf(m, x); }
            }
        }
        m = fmaxf(m, __shfl_xor(m, 16)); m = fmaxf(m, __shfl_xor(m, 32)); m = fmaxf(m, sink);
        float l = 0.f;
#pragma unroll
        for (int kt = 0; kt < 10; ++kt) {
            if (kt == (qt == 0 ? 9 : 0)) continue;
#pragma unroll
            for (int j = 0; j < 4; ++j) { const float pv = __builtin_amdgcn_exp2f(sT[kt][j] - m); sT[kt][j] = pv; l += pv; }
        }
        l += __shfl_xor(l, 16); l += __shfl_xor(l, 32); l += __builtin_amdgcn_exp2f(sink - m);
        const float inv = 1.f / l;
        f32x4 oT[4];
#pragma unroll
        for (int dt = 0; dt < 4; ++dt) oT[dt] = (f32x4){0.f, 0.f, 0.f, 0.f};
#pragma unroll
        for (int ks = 0; ks < 5; ++ks) {
            const f32x4 s0 = sT[2 * ks], s1 = sT[2 * ks + 1];
            const bf16x8 pb = __builtin_bit_cast(bf16x8, (u32x4){pk2(s0[0], s0[1]), pk2(s0[2], s0[3]), pk2(s1[0], s1[1]), pk2(s1[2], s1[3])});
#pragma unroll
            for (int dt = 0; dt < 4; ++dt) {
                const u32x2 v0 = *(const LAS u32x2*)(lds + AT_V + (16 * dt + c) * 336 + (32 * ks + 4 * g) * 2), v1 = *(const LAS u32x2*)(lds + AT_V + (16 * dt + c) * 336 + (32 * ks + 16 + 4 * g) * 2);
                const bf16x8 vf = __builtin_bit_cast(bf16x8, (u32x4){v0.x, v0.y, v1.x, v1.y});
                oT[dt] = __builtin_amdgcn_mfma_f32_16x16x32_bf16(vf, pb, oT[dt], 0, 0, 0);
            }
            __builtin_amdgcn_sched_barrier(0);
        }
        const int qidx = 16 * qt + c; const bool ok = isP ? (t0 + qidx < TP) : (qidx < 8);
        if (ok) {
            const size_t ro = (size_t)(qrowbase + qidx) * EW + hh * 64 + 4 * g;
#pragma unroll
            for (int dt = 0; dt < 4; ++dt) { const u32x2 gt = PRE ? gpre[qt][dt] : *(const u32x2*)(GA + ro + 16 * dt); const f32x4 ov = oT[dt] * inv;
                u32x2 wv = {pk2(ov[0] * bflo(gt.x), ov[1] * bfhi(gt.x)), pk2(ov[2] * bflo(gt.y), ov[3] * bfhi(gt.y))}; *(u32x2*)(OA + ro + 16 * dt) = wv; }
        }
        __builtin_amdgcn_sched_barrier(0);
    }
}

DI void attn_kv_load(const bf16_t* KS, const bf16_t* VTS, int u, int tid, u32x4 (&kr)[3], u32x4 (&vr)[3]) {
    const int b = u / 520, rem = u - b * 520, kvh = rem / 65, t0 = 32 * (rem - kvh * 65);
#pragma unroll
    for (int r = 0; r < 3; ++r) {
        int q = tid + 512 * r; q = q < 1280 ? q : 1279;
        const int key = q >> 3, part = q & 7; int s = t0 - 128 + key; s = s < 0 ? 0 : s;
        kr[r] = *(const u32x4*)(KS + (size_t)(b * TP + s) * 512 + kvh * 64 + part * 8);
        const int d = q / 20, chn = q - d * 20; int s0 = t0 - 128 + 8 * chn; s0 = s0 < 0 ? 0 : s0;
        vr[r] = *(const u32x4*)(VTS + (size_t)(kvh * 64 + d) * MP + b * TP + s0);
    }
}
DI void attn_kv_store(LAS unsigned char* lds, int u, int tid, const u32x4 (&kr)[3], const u32x4 (&vr)[3]) {
    const int b = u / 520, rem = u - b * 520, kvh = rem / 65, t0 = 32 * (rem - kvh * 65);
#pragma unroll
    for (int r = 0; r < 3; ++r) {
        const int q = tid + 512 * r;
        if (q < 1280) {
            const int key = q >> 3, part = q & 7, s = t0 - 128 + key;
            *(LAS u32x4*)(lds + AT_K + key * 144 + part * 16) = s >= 0 ? kr[r] : (u32x4){0u, 0u, 0u, 0u};
            const int d = q / 20, chn = q - d * 20, s0 = t0 - 128 + 8 * chn;
            *(LAS u32x4*)(lds + AT_V + d * 336 + chn * 16) = s0 >= 0 ? vr[r] : (u32x4){0u, 0u, 0u, 0u};
        }
    }
}

DI void attn_phase(LAS unsigned char* lds, const Params& p, int layer, const bf16_t* QA, const bf16_t* KS, const bf16_t* VTS, const bf16_t* GA, bf16_t* OA) {
    int tid = threadIdx.x; asm volatile("" : "+v"(tid));
    const int lane = tid & 63, w = __builtin_amdgcn_readfirstlane(tid >> 6), c = lane & 15, g = lane >> 4;
    const int G = gridDim.x;
    {
        u32x4 kr[3], vr[3];
        int u = blockIdx.x;
        if (u < 2080) attn_kv_load(KS, VTS, u, tid, kr, vr);
        for (; u < 2080; u += G) {
            const int b = u / 520, rem = u - b * 520, kvh = rem / 65, t0 = 32 * (rem - kvh * 65), qrowbase = b * TP + t0;
            const int hh = kvh * 8 + w;
            bf16x8 qpre[2][2]; u32x2 gpre[2][4];
#pragma unroll
            for (int qt = 0; qt < 2; ++qt) {
#pragma unroll
                for (int kk = 0; kk < 2; ++kk) qpre[qt][kk] = *(const bf16x8*)(QA + (size_t)(qrowbase + 16 * qt + c) * EW + hh * 64 + 32 * kk + 8 * g);
#pragma unroll
                for (int dt = 0; dt < 4; ++dt) gpre[qt][dt] = *(const u32x2*)(GA + (size_t)(qrowbase + 16 * qt + c) * EW + hh * 64 + 4 * g + 16 * dt);
            }
            lds_barrier();
            attn_kv_store(lds, u, tid, kr, vr);
            const int un = (u + G) < 2080 ? (u + G) : u;
            attn_kv_load(KS, VTS, un, tid, kr, vr);
            lds_barrier();
            const float slope = exp2f(-(float)(hh + 1) * 0.125f) * 1.4426950408889634f, sink = p.in[15][layer * 64 + hh] * 1.4426950408889634f;
            attn_compute<true>(lds, QA, GA, OA, true, t0, qrowbase, hh, slope, sink, c, g, qpre, gpre);
        }
    }
    for (int u = 2080 + blockIdx.x; u < 2336; u += G) {
        const int s = u - 2080, b = s >> 3, kvh = s & 7, qrowbase = NPR + 8 * b;
        __syncthreads();
        {
            const float* ck = p.in[3]; const float* cv = p.in[4];
            for (int q = tid; q < 1280; q += 512) {
                const int key = q >> 3, part = q & 7;
                u32x4 v = {0u, 0u, 0u, 0u};
                if (key < 128) { const f32x4* src = (const f32x4*)(ck + (size_t)((b * 128 + key) * 8 + kvh) * 64 + part * 8); const f32x4 x0 = src[0], x1 = src[1];
                    v = (u32x4){pk2(x0.x, x0.y), pk2(x0.z, x0.w), pk2(x1.x, x1.y), pk2(x1.z, x1.w)}; }
                else if (key < 136) v = *(const u32x4*)(KS + (size_t)(NPR + 8 * b + key - 128) * 512 + kvh * 64 + part * 8);
                *(LAS u32x4*)(lds + AT_K + key * 144 + part * 16) = v;
            }
            for (int q = tid; q < 1280; q += 512) {
                const int d = q & 63, chn = q >> 6;
                u32x4 v = {0u, 0u, 0u, 0u};
                if (chn < 16) { float x[8];
#pragma unroll
                    for (int e = 0; e < 8; ++e) x[e] = cv[(size_t)((b * 128 + 8 * chn + e) * 8 + kvh) * 64 + d];
                    v = (u32x4){pk2(x[0], x[1]), pk2(x[2], x[3]), pk2(x[4], x[5]), pk2(x[6], x[7])}; }
                else if (chn == 16) v = *(const u32x4*)(VTS + (size_t)(kvh * 64 + d) * MP + NPR + 8 * b);
                *(LAS u32x4*)(lds + AT_V + d * 336 + chn * 16) = v;
            }
        }
        __syncthreads();
        const int hh = kvh * 8 + w;
        const float slope = exp2f(-(float)(hh + 1) * 0.125f) * 1.4426950408889634f, sink = p.in[15][layer * 64 + hh] * 1.4426950408889634f;
        bf16x8 qd[2][2]; u32x2 gd[2][4];
#pragma unroll
        for (int qt = 0; qt < 2; ++qt) {
#pragma unroll
            for (int kk = 0; kk < 2; ++kk) qd[qt][kk] = (bf16x8){0, 0, 0, 0, 0, 0, 0, 0};
#pragma unroll
            for (int dt = 0; dt < 4; ++dt) gd[qt][dt] = (u32x2){0u, 0u};
        }
        attn_compute<false>(lds, QA, GA, OA, false, 0, qrowbase, hh, slope, sink, c, g, qd, gd);
    }
}

#define XB_TMO      128
#define XB_XCNT(j)  (256  + 64 * (j))
#define XB_XSUB(j)  (1280 + 64 * (j))
#define XB_XGEN(j)  (2304 + 64 * (j))
#define XB_TOP      3328
#define XB_TOPGEN   3392
#define XCD_BAR_WORDS 3456
#define XB_SPIN_CAP (1u << 18)

__device__ __forceinline__ unsigned xb_ld(unsigned* p)              { return __hip_atomic_load(p, __ATOMIC_RELAXED, __HIP_MEMORY_SCOPE_AGENT); }
__device__ __forceinline__ unsigned xb_add(unsigned* p, unsigned v) { return __hip_atomic_fetch_add(p, v, __ATOMIC_RELAXED, __HIP_MEMORY_SCOPE_AGENT); }
__device__ __forceinline__ unsigned xb_xcc_id() { return (unsigned)__builtin_amdgcn_s_getreg((3 << 11) | 20) & 0xFu; }
#define XB_SPIN(cond, bar) do { unsigned _sp = 0; while (cond) { __builtin_amdgcn_s_sleep(1); \
    if ((++_sp & 255u) == 0u) { if (xb_ld(&(bar)[XB_TMO])) break; if (_sp > XB_SPIN_CAP) { atomicAdd(&(bar)[XB_TMO], 1u); break; } } } } while (0)

struct XcdBarrier {
    unsigned* bar; unsigned x;
    volatile LAS unsigned* st;
};

__device__ __forceinline__ XcdBarrier xcd_barrier_post(unsigned* bar, volatile LAS unsigned* st) {
    XcdBarrier b; b.bar = bar; b.x = xb_xcc_id(); b.st = st;
    if (threadIdx.x == 0) (void)xb_add(&bar[XB_XCNT(b.x)], 1u);
    return b;
}
__device__ __forceinline__ void xcd_barrier_complete(unsigned* bar, unsigned x, unsigned& nloc, unsigned& nx) {
    const unsigned G = gridDim.x * gridDim.y * gridDim.z;
    unsigned sum, cnt, mine, sp = 0u;
    for (;;) {
        sum = 0u; cnt = 0u; mine = 0u;
#pragma unroll
        for (unsigned j = 0; j < 16; ++j) { const unsigned c = xb_ld(&bar[XB_XCNT(j)]); sum += c; cnt += (c > 0u) ? 1u : 0u; mine = (j == x) ? c : mine; }
        if (sum == G) break;
        __builtin_amdgcn_s_sleep(1);
        if ((++sp & 255u) == 0u) { if (xb_ld(&bar[XB_TMO])) break; if (sp > XB_SPIN_CAP) { atomicAdd(&bar[XB_TMO], 1u); break; } }
    }
    nloc = mine > 0u ? mine : 1u; nx = cnt > 0u ? cnt : 1u;
}

__device__ __forceinline__ void xcd_barrier(const XcdBarrier& b) {
    asm volatile("s_waitcnt vmcnt(0)" ::: "memory");
    __syncthreads();
    if (threadIdx.x == 0) {
        unsigned* bar = b.bar;
        __builtin_amdgcn_s_waitcnt(0);
        unsigned nloc = b.st[0], nx = b.st[1];
        if (nloc == 0u) { xcd_barrier_complete(bar, b.x, nloc, nx); b.st[0] = nloc; b.st[1] = nx; }
        const unsigned old = xb_add(&bar[XB_XSUB(b.x)], 1u);
        const unsigned gen = old / nloc;
        if (old + 1u == (gen + 1u) * nloc) {
            __builtin_amdgcn_fence(__ATOMIC_RELEASE, "agent");
            asm volatile("s_waitcnt vmcnt(0)" ::: "memory");
            const unsigned og = xb_add(&bar[XB_TOP], 1u);
            const unsigned tg = og / nx;
            if (og + 1u == (tg + 1u) * nx) xb_add(&bar[XB_TOPGEN], 1u);
            else XB_SPIN(xb_ld(&bar[XB_TOPGEN]) == tg, bar);
            __builtin_amdgcn_fence(__ATOMIC_ACQUIRE, "agent");
            xb_add(&bar[XB_XGEN(b.x)], 1u);
            asm volatile("s_waitcnt vmcnt(0)" ::: "memory");
        } else {
            XB_SPIN(xb_ld(&bar[XB_XGEN(b.x)]) == gen, bar);
            __builtin_amdgcn_fence(__ATOMIC_ACQUIRE, "agent");
            asm volatile("s_waitcnt vmcnt(0)" ::: "memory");
        }
    }
    __syncthreads();
}


DI void norm_phase(const Params& p, int mode) {
    int tid = threadIdx.x; asm volatile("" : "+v"(tid));
    const int lane = tid & 63, wave = __builtin_amdgcn_readfirstlane(tid >> 6);
    const int gw = blockIdx.x * 8 + wave, NGW = gridDim.x * 8;
    float* X = (float*)(p.ws + OFF_X); bf16_t* XB = (bf16_t*)(p.ws + OFF_XB);
    if (mode == 1) {
        const bf16_t* KS = (const bf16_t*)(p.ws + OFF_KS); const bf16_t* VTS = (const bf16_t*)(p.ws + OFF_VTS);
        const int gt = blockIdx.x * 512 + tid, NT = gridDim.x * 512;
        for (int i = gt; i < (512 + 256) * 512; i += NT) {
            const int r = i >> 9, col = i & 511;
            int row; size_t dk, dv;
            if (r < 512) { const int b = r >> 7, t = r & 127; row = b * TP + (TP - 128) + t; dk = O_CKP + (size_t)r * 512 + col; dv = O_CVP + (size_t)r * 512 + col; }
            else { const int s = r - 512; row = NPR + s; const size_t o = (size_t)((s >> 3) * 128 + 120 + (s & 7)) * 512 + col; dk = O_CKS + o; dv = O_CVS + o; }
            p.out[dk] = bf2f(KS[(size_t)row * 512 + col]);
            p.out[dv] = bf2f(VTS[(size_t)col * MP + row]);
        }
    }
    for (int m = gw; m < MT; m += NGW) {
        if (mode == 0) norm_row(X + (size_t)m * D, nullptr, XB + (size_t)m * D, nullptr, nullptr, lane);
        else if (mode == 1) {
            float* dst;
            if (m < NPR) { const int b = m / TP, t = m - b * TP; if (t < 16) continue; dst = p.out + O_YP + (size_t)(b * 2048 + t - 16) * D; }
            else dst = p.out + O_YS + (size_t)(m - NPR) * D;
            norm_row(X + (size_t)m * D, nullptr, nullptr, dst, p.in[17], lane);
        } else {
            const float* src;
            if (m < NPR) { const int b = m / TP, t = m - b * TP; src = t < 16 ? p.in[5] + (size_t)t * D : p.in[0] + (size_t)(b * 2048 + t - 16) * D; }
            else src = p.in[1] + (size_t)(m - NPR) * D;
            norm_row(src, X + (size_t)m * D, XB + (size_t)m * D, nullptr, nullptr, lane, (float*)(p.ws + OFF_SS) + m);
        }
    }
}

DI void reduce_phase(const Params& p, int ssidx) {
    int tid = threadIdx.x; asm volatile("" : "+v"(tid));
    const int lane = tid & 63, wave = __builtin_amdgcn_readfirstlane(tid >> 6);
    const int G = gridDim.x, NGW = G * 8;
    float* X = (float*)(p.ws + OFF_X); bf16_t* XB = (bf16_t*)(p.ws + OFF_XB); float* SS = (float*)(p.ws + OFF_SS) + (size_t)ssidx * MP; const float* P = (const float*)(p.ws + OFF_Q);
    for (int task = wave * G + (int)blockIdx.x; task < (MT - 8192) * 8; task += NGW) {
        const int r = 8192 + (task >> 3), j = task & 7;
        const int pmi = (r - 8192) >> 8, rr = (r - 8192) & 255;
        const float* pp = P + (size_t)((pmi * 8 + j) * 16) * 65536 + rr * 256 + lane * 4;
        f32x4 s = *(const f32x4*)(X + (size_t)r * D + j * 256 + lane * 4);
        f32x4 t[16];
#pragma unroll
        for (int kp = 0; kp < 16; ++kp) t[kp] = *(const f32x4*)(pp + (size_t)kp * 65536);
#pragma unroll
        for (int kp = 0; kp < 16; ++kp) s = s + t[kp];
        *(f32x4*)(X + (size_t)r * D + j * 256 + lane * 4) = s;
        *(u32x2*)(XB + (size_t)r * D + j * 256 + lane * 4) = (u32x2){pk2(s.x, s.y), pk2(s.z, s.w)};
        const float ss = wave_sum((s.x * s.x + s.y * s.y) + (s.z * s.z + s.w * s.w));
        if (lane == 0) __hip_atomic_fetch_add(SS + r, ss, __ATOMIC_RELAXED, __HIP_MEMORY_SCOPE_AGENT);
    }
}

DI void prologue_phase(LAS unsigned char* lds, const Params& p) {
    int tid = threadIdx.x; asm volatile("" : "+v"(tid));
    const int lane = tid & 63, wave = __builtin_amdgcn_readfirstlane(tid >> 6);
    const int G = gridDim.x, bid = blockIdx.x, gw = bid * 8 + wave, NGW = G * 8;
    float* LB = (float*)(p.ws + OFF_LB);
    convert_set(lds, p, 0, gw, NGW, lane, wave);
    const int gt = bid * 512 + tid, NT = G * 512;
    for (int i = gt; i < 4 * MP; i += NT) ((float*)(p.ws + OFF_SS))[MP + i] = 0.f;
    for (int i = gt; i < 2 * 2048; i += NT) { const int cc = i & 2047; LB[i] = i < 2048 ? 0.f : 1.f / (1.f + __expf(p.in[8][cc] - p.in[8][2048 + cc])); }
    for (int i = gt; i < 32 * 120 * 128; i += NT) { const int bs = i / (120 * 128), r = i - bs * (120 * 128);
        ((f32x4*)(p.out + O_CKS))[(size_t)bs * 128 * 128 + r] = ((const f32x4*)p.in[3])[(size_t)bs * 128 * 128 + 8 * 128 + r];
        ((f32x4*)(p.out + O_CVS))[(size_t)bs * 128 * 128 + r] = ((const f32x4*)p.in[4])[(size_t)bs * 128 * 128 + 8 * 128 + r]; }
}

__global__ void __launch_bounds__(512) yoco_fwd(Params p) {
    extern __shared__ __attribute__((aligned(16))) unsigned char lds_raw[];
    LAS unsigned char* lds = (LAS unsigned char*)lds_raw;
    cg::grid_group grid = cg::this_grid();
    if (threadIdx.x == 0) { ((volatile LAS unsigned*)(lds + LDS_ST))[0] = 0u; ((volatile LAS unsigned*)(lds + LDS_ST))[1] = 0u; }
    __syncthreads();
    const XcdBarrier xbar = xcd_barrier_post((unsigned*)(p.ws + OFF_CTL), (volatile LAS unsigned*)(lds + LDS_ST));
    constexpr int NPH = 18;
#pragma unroll 1
    for (int ph = 0; ph < NPH; ++ph) {
        int kind, arg;
        switch (ph) {
            case 0: kind = 0; arg = 0; break;
            case 1: kind = 2; arg = 0; break;   case 2: kind = 3; arg = 0; break;   case 3: kind = 4; arg = 0; break;   case 4: kind = 7; arg = 0; break;
            case 5: kind = 2; arg = 1; break;   case 6: kind = 3; arg = 1; break;   case 7: kind = 4; arg = 1; break;   case 8: kind = 7; arg = 1; break;
            case 9: kind = 5; arg = 0; break;   case 10: kind = 6; arg = 0; break;  case 11: kind = 4; arg = 2; break;  case 12: kind = 7; arg = 2; break;
            case 13: kind = 5; arg = 1; break;  case 14: kind = 6; arg = 1; break;  case 15: kind = 4; arg = 3; break;  case 16: kind = 7; arg = 3; break;
            default: kind = 1; arg = 1; break;
        }
        asm volatile("" : "+s"(kind), "+s"(arg));
        unsigned char* ws = p.ws;
        const int G = gridDim.x, bid = blockIdx.x;
        if (kind == 0) { prologue_phase(lds, p); norm_phase(p, 2); }
        else if (kind == 1) norm_phase(p, arg);
        else if (kind == 2) {
            const int l = arg;
            GSched S; S.X = (const char*)(ws + OFF_XB); S.W = (const char*)(ws + OFF_WIN_A) + (size_t)l * 12288 * D * 2; S.K = D; S.nM = 34; S.nN = 48; S.pn0 = 0; S.t0 = 32; S.t1 = 48; S.G = G; S.c = bid; S.split = 0;
            EpiHgrnIn E{(bf16_t*)(ws + OFF_Q), (bf16_t*)(ws + OFF_K), (float*)(ws + OFF_LF), (bf16_t*)(ws + OFF_VT), (bf16_t*)(ws + OFF_G), (const float*)(ws + OFF_LB) + l * 2048, (const float*)(ws + OFF_SS) + (size_t)l * MP, p.in[9] + l * 256};
            gemm_phase(lds, S, E);
        } else if (kind == 3) {
            scan_phase(lds, p, arg, true, (const bf16_t*)(ws + OFF_Q), (const bf16_t*)(ws + OFF_K), (const float*)(ws + OFF_LF), (const bf16_t*)(ws + OFF_VT), (const bf16_t*)(ws + OFF_G), (bf16_t*)(ws + OFF_OG));
        } else if (kind == 4) {
            GSched S; S.X = (const char*)(ws + OFF_OG); S.W = (const char*)(ws + (arg < 2 ? OFF_WOUT_A : OFF_WOUT_B)) + (size_t)(arg & 1) * D * EW * 2; S.K = EW; S.nM = 34; S.nN = 8; S.pn0 = 0; S.t0 = 0; S.t1 = 0; S.G = G; S.c = bid; S.split = 1;
            EpiOut E{(float*)(ws + OFF_X), (bf16_t*)(ws + OFF_XB), (float*)(ws + OFF_SS) + (size_t)(arg + 1) * MP, (float*)(ws + OFF_Q)};
            gemm_phase(lds, S, E);
        } else if (kind == 5) {
            const int l = arg;
            GSched S; S.X = (const char*)(ws + OFF_XB); S.W = (const char*)(ws + OFF_WKV) + (size_t)l * 8192 * D * 2; S.K = D; S.nM = 34; S.nN = l == 0 ? 36 : 32; S.pn0 = l == 0 ? 0 : 4; S.t0 = 2; S.t1 = 4; S.G = G; S.c = bid; S.split = 0;
            EpiSwaIn E{(bf16_t*)(ws + OFF_KS), (bf16_t*)(ws + OFF_VTS), (bf16_t*)(ws + OFF_Q), (bf16_t*)(ws + OFF_G), (const float*)(ws + OFF_SS) + (size_t)(2 + l) * MP};
            gemm_phase(lds, S, E);
        } else if (kind == 7) {
            reduce_phase(p, arg + 1);
        } else if (kind == 6) {
            attn_phase(lds, p, arg, (const bf16_t*)(ws + OFF_Q), (const bf16_t*)(ws + OFF_KS), (const bf16_t*)(ws + OFF_VTS), (const bf16_t*)(ws + OFF_G), (bf16_t*)(ws + OFF_OG));
        }
        if (ph + 1 < NPH) { if (gridDim.x == 0x7fffffffu) grid.sync(); else xcd_barrier(xbar); }
    }
}

extern "C" void kernel_launch(void* const* d_in, const int* in_sizes, int n_in, void* d_out, int out_size, void* d_ws, size_t ws_size, hipStream_t stream) {
    static int grid_blocks = 0;
    if (grid_blocks == 0) {
        if (n_in != 18 || ws_size < WS_END) { fprintf(stderr, "kernel_launch: unexpected n_in %d / ws_size %zu (need %zu)\n", n_in, ws_size, (size_t)WS_END); grid_blocks = -1; return; }
        int dev = 0, cus = 0, per_cu = 0;
        hipGetDevice(&dev);
        hipDeviceGetAttribute(&cus, hipDeviceAttributeMultiprocessorCount, dev);
        hipFuncSetAttribute((const void*)yoco_fwd, hipFuncAttributeMaxDynamicSharedMemorySize, LDS_BYTES);
        hipOccupancyMaxActiveBlocksPerMultiprocessor(&per_cu, (const void*)yoco_fwd, 512, LDS_BYTES);
        if (per_cu < 1) { fprintf(stderr, "kernel_launch: occupancy query returned %d\n", per_cu); per_cu = 1; }
        grid_blocks = cus * 1;
    }
    if (grid_blocks < 0) return;
    if (hipMemsetAsync((char*)d_ws + OFF_CTL, 0, CTL_BYTES, stream) != hipSuccess) { fprintf(stderr, "kernel_launch: memset of the barrier words failed\n"); return; }
    Params p{};
    for (int i = 0; i < 18; ++i) p.in[i] = (const float*)d_in[i];
    p.out = (float*)d_out; p.ws = (unsigned char*)d_ws;
    void* args[] = {&p};
    hipError_t e = hipLaunchCooperativeKernel((const void*)yoco_fwd, dim3(grid_blocks), dim3(512), args, LDS_BYTES, stream);
    if (e != hipSuccess) fprintf(stderr, "cooperative launch failed: %s (grid %d)\n", hipGetErrorString(e), grid_blocks);
}
```

```cpp
#include <hip/hip_runtime.h>
#include <hip/hip_cooperative_groups.h>
#include <cstdio>
#include <cstdint>
namespace cg = cooperative_groups;

#define LAS __attribute__((address_space(3)))
#define DI __device__ __forceinline__
typedef unsigned short bf16_t;
typedef short bf16x8 __attribute__((ext_vector_type(8)));
typedef float f32x4 __attribute__((ext_vector_type(4)));
typedef float f32x2 __attribute__((ext_vector_type(2)));
typedef unsigned u32x4 __attribute__((ext_vector_type(4)));
typedef unsigned u32x2 __attribute__((ext_vector_type(2)));
typedef __bf16 bf2_t __attribute__((ext_vector_type(2)));

constexpr int D = 2048, EW = 4096, TP = 2064, NPR = 8256, MT = 8512, MP = 8704;
constexpr float EPS = 1e-6f;
constexpr size_t O_YP = 0, O_YS = 16777216, O_SP = 17301504, O_CKP = 21495808, O_CVP = 21757952, O_SS = 22020096, O_CKS = 55574528, O_CVS = 57671680;
constexpr size_t OFF_WIN_A = 0, OFF_WOUT_A = 100663296, OFF_WKV = 134217728, OFF_WIN_B = 138412032, OFF_WOUT_B = 205520896,
                 OFF_X = 239075328, OFF_XB = 310378496, OFF_Q = 346030080, OFF_K = 381681664, OFF_LF = 417333248, OFF_VT = 488636416,
                 OFF_G = 559939584, OFF_OG = 631242752, OFF_KS = 702545920, OFF_VTS = 711458816, OFF_LB = 720371712, OFF_CTL = 720388096, CTL_BYTES = 16384, OFF_SS = 720404480, WS_END = 720404480 + 5 * 8704 * 4;
constexpr int LDS_BYTES = 155712, LDS_ST = 155648;

struct Params { const float* in[18]; float* out; unsigned char* ws; };

DI unsigned pk2(float a, float b) { f32x2 v = {a, b}; bf2_t r = __builtin_convertvector(v, bf2_t); return __builtin_bit_cast(unsigned, r); }
DI float bflo(unsigned u) { return __uint_as_float(u << 16); }
DI float bfhi(unsigned u) { return __uint_as_float(u & 0xffff0000u); }
DI float bf2f(bf16_t h) { return __uint_as_float((unsigned)h << 16); }
DI float fsilu(float v) { return v * __builtin_amdgcn_rcpf(1.f + __expf(-v)); }
DI void lds_barrier() { asm volatile("s_waitcnt lgkmcnt(0)" ::: "memory"); __builtin_amdgcn_s_barrier(); asm volatile("" ::: "memory"); }
DI float wave_sum(float v) {
#pragma unroll
    for (int o = 1; o < 64; o <<= 1) v += __shfl_xor(v, o);
    return v;
}

constexpr int BM = 256, BK = 64, HALF = 128, HTB = HALF * BK * 2;
DI int lds_byte(int r, int c) { const int st = (r >> 4) * 2 + (c >> 5), rr = r & 15, cc = c & 31, ob = rr * 64 + cc * 2; return st * 1024 + (ob ^ (((ob >> 9) & 1) << 5)); }
DI void stage_rc(int b, int& R, int& C) { const int st = b / 1024, sb = b % 1024, swz = sb ^ (((sb >> 9) & 1) << 5); R = (st >> 1) * 16 + swz / 64; C = (st & 1) * 32 + (swz % 64) / 2; }
DI int perm32(int rho) { const int n = rho >> 4, i = rho & 15; return 8 * (i >> 2) + 4 * n + (i & 3); }

struct GUnit { const char* a; const char* b; int pm, pn, nt, piece; };
struct GSched {
    const char* X; const char* W; int K, nM, nN, pn0, t0, t1, G, c, split;
    DI bool next(int i, GUnit& u) const {
        const long L = (long)i * G + c; const int nMf = split ? 32 : nM; const int nwg = nMf * nN;
        const size_t tstep = (size_t)BM * K * 2;
        if (L >= nwg) {
            if (!split) return false;
            const int idx = (int)(L - nwg); if (idx >= 256) return false;
            const int uu = idx >> 4, kp = idx & 15;
            u.pm = 32 + (uu >> 3); u.pn = uu & 7; u.nt = 4; u.piece = idx;
            u.a = X + (size_t)u.pm * tstep + (size_t)kp * 512; u.b = W + (size_t)u.pn * tstep + (size_t)kp * 512;
            return true;
        }
        int wgid = (int)L; { const int q = nwg / 8, r = nwg % 8, xcd = wgid % 8, off = wgid / 8; wgid = (xcd < r ? xcd * (q + 1) : r * (q + 1) + (xcd - r) * q) + off; }
        const int nig = 8 * nN, gid = wgid / nig, fm = gid * 8, gsz = (nMf - fm) < 8 ? (nMf - fm) : 8;
        u.pm = fm + ((wgid % nig) % gsz); u.pn = pn0 + (wgid % nig) / gsz; u.nt = K / BK; u.piece = -1;
        const char* xp = X + (size_t)u.pm * tstep; const char* wp = W + (size_t)u.pn * tstep;
        const bool tr = (u.pn >= t0) && (u.pn < t1);
        u.a = tr ? wp : xp; u.b = tr ? xp : wp;
        return true;
    }
};

template <class Epi>
DI void gemm_phase(LAS unsigned char* lds, const GSched& S, const Epi& E) {
    int tid = threadIdx.x; asm volatile("" : "+v"(tid));
    const int wid = __builtin_amdgcn_readfirstlane(tid >> 6), lane = tid & 63, wr = wid >> 2, wc = wid & 3, fr = lane & 15, fq = lane >> 4;
    const int K = S.K;
    unsigned voffA[2], voffB[2];
#pragma unroll
    for (int i = 0; i < 2; ++i) { int R, C; stage_rc(tid * 16 + i * 8192, R, C); const int Rb = (R & ~31) + perm32(R & 31);
        voffA[i] = (unsigned)(R * K + C) * 2u; voffB[i] = (unsigned)(Rb * K + C) * 2u; }
    const size_t kstep = (size_t)(BK * 2);
    const size_t hstep = (size_t)HALF * K * 2;
    const unsigned ldsw = (unsigned)wid * 1024u;
    const int aoff = lds_byte(wr * 64 + fr, fq * 8), boff = lds_byte(wc * 32 + fr, fq * 8);
#define PG8_SA(b, h) (((b) * 2 + (h)) * HTB)
#define PG8_SB(b, h) ((4 + (b) * 2 + (h)) * HTB)
#define PG8_STAGE(bufoff, gbase, voff) do { _Pragma("unroll") for (int _i = 0; _i < 2; ++_i) \
        __builtin_amdgcn_global_load_lds((const unsigned*)((const char*)(gbase) + (voff)[_i]), (LAS unsigned*)(lds + (bufoff) + ldsw + _i * 8192), 16, 0, 0); } while (0)
#define PG8_LDA(dst, b, h) do { _Pragma("unroll") for (int m = 0; m < 4; ++m) _Pragma("unroll") for (int k = 0; k < 2; ++k) dst[m][k] = *(const LAS bf16x8*)(lds + PG8_SA(b, h) + aoff + m * 2048 + k * 1024); } while (0)
#define PG8_LDB(dst, b, h) do { _Pragma("unroll") for (int n = 0; n < 2; ++n) _Pragma("unroll") for (int k = 0; k < 2; ++k) dst[n][k] = *(const LAS bf16x8*)(lds + PG8_SB(b, h) + boff + n * 2048 + k * 1024); } while (0)
#define PG8_MMA(ai, bj, At, Bt) do { __builtin_amdgcn_s_setprio(1); _Pragma("unroll") for (int m = 0; m < 4; ++m) _Pragma("unroll") for (int n = 0; n < 2; ++n) _Pragma("unroll") for (int k = 0; k < 2; ++k) \
        acc[ai][bj][m][n] = __builtin_amdgcn_mfma_f32_16x16x32_bf16(Bt[n][k], At[m][k], acc[ai][bj][m][n], 0, 0, 0); __builtin_amdgcn_s_setprio(0); } while (0)
#define PG8_WAIT_V(n) asm volatile("s_waitcnt vmcnt(" #n ")" ::: "memory")
#define PG8_WAIT_L(n) asm volatile("s_waitcnt lgkmcnt(" #n ")" ::: "memory")
#define PG8_BAR __builtin_amdgcn_s_barrier()
#define PG8_SCHED __builtin_amdgcn_sched_barrier(0)
    GUnit cur, nxt; int ui = 0;
    if (!S.next(0, cur)) return;
    f32x4 acc[2][2][4][2];
#pragma unroll
    for (int a = 0; a < 2; ++a)
#pragma unroll
        for (int b = 0; b < 2; ++b)
#pragma unroll
            for (int m = 0; m < 4; ++m)
#pragma unroll
                for (int n = 0; n < 2; ++n) acc[a][b][m][n] = (f32x4){0.f, 0.f, 0.f, 0.f};
    bf16x8 At[4][2], B0[2][2], B1[2][2];
    const char* cA = cur.a; const char* cB = cur.b;
    PG8_STAGE(PG8_SB(0, 0), cB, voffB); PG8_STAGE(PG8_SB(0, 1), cB + hstep, voffB); PG8_STAGE(PG8_SA(0, 0), cA, voffA); PG8_STAGE(PG8_SA(0, 1), cA + hstep, voffA);
    if (wr == 1) PG8_BAR;
    PG8_WAIT_V(2); PG8_BAR;
    PG8_STAGE(PG8_SB(1, 0), cB + kstep, voffB); PG8_STAGE(PG8_SA(1, 0), cA + kstep, voffA); PG8_STAGE(PG8_SB(1, 1), cB + hstep + kstep, voffB);
    PG8_WAIT_V(6); PG8_BAR;
    for (;;) {
        const bool has_next = S.next(ui + 1, nxt);
        const char* nA = has_next ? nxt.a : cA; const char* nB = has_next ? nxt.b : cB;
        const int nt = cur.nt;
        for (int t = 0; t < nt; t += 2) {
            const bool last = (t == nt - 2);
            const char* a1 = cA + (size_t)(t + 1) * kstep;
            const char* a2 = last ? nA : cA + (size_t)(t + 2) * kstep; const char* b2 = last ? nB : cB + (size_t)(t + 2) * kstep;
            const char* a3 = a2 + kstep; const char* b3 = b2 + kstep;
            PG8_LDB(B0, 0, 0); PG8_LDB(B1, 0, 1); PG8_SCHED; PG8_LDA(At, 0, 0); PG8_STAGE(PG8_SA(1, 1), a1 + hstep, voffA);
            PG8_WAIT_V(8); PG8_WAIT_L(0); PG8_BAR; PG8_MMA(0, 0, At, B0); PG8_MMA(0, 1, At, B1); PG8_BAR; PG8_SCHED;
            PG8_LDA(At, 0, 1); PG8_STAGE(PG8_SB(0, 0), b2, voffB); PG8_STAGE(PG8_SB(0, 1), b2 + hstep, voffB); PG8_STAGE(PG8_SA(0, 0), a2, voffA);
            PG8_WAIT_V(8); PG8_WAIT_L(0); PG8_BAR; PG8_MMA(1, 0, At, B0); PG8_MMA(1, 1, At, B1); PG8_BAR; PG8_SCHED;
            PG8_LDB(B0, 1, 0); PG8_LDB(B1, 1, 1); PG8_SCHED; PG8_LDA(At, 1, 0); PG8_STAGE(PG8_SA(0, 1), a2 + hstep, voffA);
            PG8_WAIT_V(8); PG8_WAIT_L(0); PG8_BAR; PG8_MMA(0, 0, At, B0); PG8_MMA(0, 1, At, B1); PG8_BAR; PG8_SCHED;
            PG8_LDA(At, 1, 1); PG8_STAGE(PG8_SB(1, 0), b3, voffB); PG8_STAGE(PG8_SB(1, 1), b3 + hstep, voffB); PG8_STAGE(PG8_SA(1, 0), a3, voffA);
            PG8_WAIT_V(8); PG8_WAIT_L(0); PG8_BAR; PG8_MMA(1, 0, At, B0); PG8_MMA(1, 1, At, B1); PG8_BAR; PG8_SCHED;
        }
        if (wr == 0) PG8_BAR;
        E(acc, cur, wr, wc, fr, fq);
        if (!has_next) break;
#pragma unroll
        for (int a = 0; a < 2; ++a)
#pragma unroll
            for (int b = 0; b < 2; ++b)
#pragma unroll
                for (int m = 0; m < 4; ++m)
#pragma unroll
                    for (int n = 0; n < 2; ++n) acc[a][b][m][n] = (f32x4){0.f, 0.f, 0.f, 0.f};
        cur = nxt; cA = nA; cB = nB; ++ui;
        if (wr == 1) PG8_BAR;
    }
    PG8_WAIT_V(0);
    PG8_BAR;
#undef PG8_SA
#undef PG8_SB
#undef PG8_STAGE
#undef PG8_LDA
#undef PG8_LDB
#undef PG8_MMA
#undef PG8_WAIT_V
#undef PG8_WAIT_L
#undef PG8_BAR
#undef PG8_SCHED
}

struct EpiHgrnIn {
    bf16_t* Qb; bf16_t* Kb; float* LF; bf16_t* VT; bf16_t* Gb; const float* lb; const float* SS; const float* onorm;
    DI void operator()(const f32x4 (&acc_in)[2][2][4][2], const GUnit& u, int wr, int wc, int fr, int fq) const {
        const int pn = u.pn;
        if (pn >= 32) {
            const int f0 = (pn - 32) * 256 + wr * 64 + fr, t0 = u.pm * 256 + wc * 32 + 8 * fq;
            f32x4 rt[2][2];
#pragma unroll
            for (int bj = 0; bj < 2; ++bj)
#pragma unroll
                for (int n = 0; n < 2; ++n) { const f32x4 s = *(const f32x4*)(SS + t0 + bj * 128 + 4 * n);
                    rt[bj][n] = (f32x4){__builtin_amdgcn_rsqf(s[0] * (1.f / D) + EPS), __builtin_amdgcn_rsqf(s[1] * (1.f / D) + EPS), __builtin_amdgcn_rsqf(s[2] * (1.f / D) + EPS), __builtin_amdgcn_rsqf(s[3] * (1.f / D) + EPS)}; }
#pragma unroll
            for (int ai = 0; ai < 2; ++ai)
#pragma unroll
                for (int m = 0; m < 4; ++m) { bf16_t* rowp = VT + (size_t)(f0 + ai * 128 + m * 16) * MP + t0;
#pragma unroll
                    for (int bj = 0; bj < 2; ++bj) { const f32x4 v0 = acc_in[ai][bj][m][0] * rt[bj][0], v1 = acc_in[ai][bj][m][1] * rt[bj][1];
                        u32x4 w = {pk2(v0[0], v0[1]), pk2(v0[2], v0[3]), pk2(v1[0], v1[1]), pk2(v1[2], v1[3])}; *(u32x4*)(rowp + bj * 128) = w; } }
            return;
        }
        const int row0 = u.pm * 256 + wr * 64 + fr;
        if (pn < 8) {
            const int col0 = pn * 256 + wc * 32 + 8 * fq; const float QS = 0.08838834764831845f;
#pragma unroll
            for (int ai = 0; ai < 2; ++ai)
#pragma unroll
                for (int m = 0; m < 4; ++m) { bf16_t* rowp = Qb + (size_t)(row0 + ai * 128 + m * 16) * D + col0;
                    const float rs = __builtin_amdgcn_rsqf(SS[row0 + ai * 128 + m * 16] * (1.f / D) + EPS);
#pragma unroll
                    for (int bj = 0; bj < 2; ++bj) { const f32x4 v0 = acc_in[ai][bj][m][0] * rs, v1 = acc_in[ai][bj][m][1] * rs;
                        u32x4 w = {pk2(fsilu(v0[0]) * QS, fsilu(v0[1]) * QS), pk2(fsilu(v0[2]) * QS, fsilu(v0[3]) * QS), pk2(fsilu(v1[0]) * QS, fsilu(v1[1]) * QS), pk2(fsilu(v1[2]) * QS, fsilu(v1[3]) * QS)};
                        *(u32x4*)(rowp + bj * 128) = w; } }
        } else if (pn < 16) {
            const int col0 = (pn - 8) * 256 + wc * 32 + 8 * fq;
#pragma unroll
            for (int bj = 0; bj < 2; ++bj) {
                const f32x4 l0 = *(const f32x4*)(lb + col0 + bj * 128), l1 = *(const f32x4*)(lb + col0 + bj * 128 + 4);
#pragma unroll
                for (int ai = 0; ai < 2; ++ai)
#pragma unroll
                    for (int m = 0; m < 4; ++m) { const size_t ro = (size_t)(row0 + ai * 128 + m * 16) * D + col0 + bj * 128;
                        const float rs = __builtin_amdgcn_rsqf(SS[row0 + ai * 128 + m * 16] * (1.f / D) + EPS);
                        f32x4 lf0, lf1; float kk[8];
#pragma unroll
                        for (int e = 0; e < 8; ++e) { float f = (e < 4 ? acc_in[ai][bj][m][0][e & 3] : acc_in[ai][bj][m][1][e & 3]) * rs; const float lbv = e < 4 ? l0[e & 3] : l1[e & 3];
                            f = fminf(fmaxf(f, -80.f), 80.f);
                            const float ex = __expf(-f), sig = __builtin_amdgcn_rcpf(1.f + ex), om = 1.f - lbv;
                            const float lg = __log2f(lbv + om * sig); kk[e] = om * ex * sig;
                            if (e < 4) lf0[e & 3] = lg; else lf1[e & 3] = lg; }
                        *(f32x4*)(LF + ro) = lf0; *(f32x4*)(LF + ro + 4) = lf1;
                        u32x4 w = {pk2(kk[0], kk[1]), pk2(kk[2], kk[3]), pk2(kk[4], kk[5]), pk2(kk[6], kk[7])}; *(u32x4*)(Kb + ro) = w; }
            }
        } else {
            const int col0 = (pn - 16) * 256 + wc * 32 + 8 * fq;
            f32x4 on[2][2];
#pragma unroll
            for (int bj = 0; bj < 2; ++bj) { on[bj][0] = *(const f32x4*)(onorm + wc * 32 + 8 * fq + bj * 128); on[bj][1] = *(const f32x4*)(onorm + wc * 32 + 8 * fq + bj * 128 + 4); }
#pragma unroll
            for (int ai = 0; ai < 2; ++ai)
#pragma unroll
                for (int m = 0; m < 4; ++m) { bf16_t* rowp = Gb + (size_t)(row0 + ai * 128 + m * 16) * EW + col0;
                    const float rs = __builtin_amdgcn_rsqf(SS[row0 + ai * 128 + m * 16] * (1.f / D) + EPS);
#pragma unroll
                    for (int bj = 0; bj < 2; ++bj) { const f32x4 v0 = acc_in[ai][bj][m][0] * rs, v1 = acc_in[ai][bj][m][1] * rs; const f32x4 n0 = on[bj][0], n1 = on[bj][1];
                        u32x4 w = {pk2(fsilu(v0[0]) * n0[0], fsilu(v0[1]) * n0[1]), pk2(fsilu(v0[2]) * n0[2], fsilu(v0[3]) * n0[3]), pk2(fsilu(v1[0]) * n1[0], fsilu(v1[1]) * n1[1]), pk2(fsilu(v1[2]) * n1[2], fsilu(v1[3]) * n1[3])};
                        *(u32x4*)(rowp + bj * 128) = w; } }
        }
    }
};

struct EpiOut {
    float* X; bf16_t* XB; float* SS; float* P;
    DI void operator()(const f32x4 (&acc)[2][2][4][2], const GUnit& u, int wr, int wc, int fr, int fq) const {
        if (u.piece >= 0) {
            float* pb = P + (size_t)u.piece * 65536 + (wr * 64 + fr) * 256 + wc * 32 + 8 * fq;
#pragma unroll
            for (int ai = 0; ai < 2; ++ai)
#pragma unroll
                for (int m = 0; m < 4; ++m)
#pragma unroll
                    for (int bj = 0; bj < 2; ++bj) { f32x4* q = (f32x4*)(pb + (ai * 128 + m * 16) * 256 + bj * 128); q[0] = acc[ai][bj][m][0]; q[1] = acc[ai][bj][m][1]; }
            return;
        }
        const int row0 = u.pm * 256 + wr * 64 + fr, col0 = u.pn * 256 + wc * 32 + 8 * fq;
#pragma unroll
        for (int ai = 0; ai < 2; ++ai)
#pragma unroll
            for (int m = 0; m < 4; ++m) { const int row = row0 + ai * 128 + m * 16; float* rowp = X + (size_t)row * D + col0; bf16_t* bp = XB + (size_t)row * D + col0; float ss = 0.f;
#pragma unroll
                for (int bj = 0; bj < 2; ++bj) { f32x4* p = (f32x4*)(rowp + bj * 128); const f32x4 x0 = p[0] + acc[ai][bj][m][0], x1 = p[1] + acc[ai][bj][m][1]; p[0] = x0; p[1] = x1;
                    u32x4 w = {pk2(x0[0], x0[1]), pk2(x0[2], x0[3]), pk2(x1[0], x1[1]), pk2(x1[2], x1[3])}; *(u32x4*)(bp + bj * 128) = w;
                    ss += (x0[0] * x0[0] + x0[1] * x0[1]) + (x0[2] * x0[2] + x0[3] * x0[3]) + (x1[0] * x1[0] + x1[1] * x1[1]) + (x1[2] * x1[2] + x1[3] * x1[3]); }
                ss += __shfl_xor(ss, 16); ss += __shfl_xor(ss, 32);
                if (fq == 0) __hip_atomic_fetch_add(SS + row, ss, __ATOMIC_RELAXED, __HIP_MEMORY_SCOPE_AGENT); }
    }
};

struct EpiSwaIn {
    bf16_t* KS; bf16_t* VTS; bf16_t* QA; bf16_t* GA; const float* SS;
    DI void operator()(const f32x4 (&acc)[2][2][4][2], const GUnit& u, int wr, int wc, int fr, int fq) const {
        const int pn = u.pn;
        const bool tr = (pn == 2 || pn == 3);
        bf16_t* base; int ld, r0, c0; int act;
        if (tr) { base = VTS; ld = MP; r0 = (pn - 2) * 256; c0 = u.pm * 256; act = 0; }
        else if (pn < 2) { base = KS; ld = 512; r0 = u.pm * 256; c0 = pn * 256; act = 0; }
        else if (pn < 20) { base = QA; ld = EW; r0 = u.pm * 256; c0 = (pn - 4) * 256; act = 1; }
        else { base = GA; ld = EW; r0 = u.pm * 256; c0 = (pn - 20) * 256; act = 2; }
        const int row0 = r0 + wr * 64 + fr, col0 = c0 + wc * 32 + 8 * fq;
        f32x4 rt[2][2];
#pragma unroll
        for (int bj = 0; bj < 2; ++bj)
#pragma unroll
            for (int n = 0; n < 2; ++n) { rt[bj][n] = (f32x4){1.f, 1.f, 1.f, 1.f};
                if (tr) { const f32x4 s = *(const f32x4*)(SS + col0 + bj * 128 + 4 * n);
                    rt[bj][n] = (f32x4){__builtin_amdgcn_rsqf(s[0] * (1.f / D) + EPS), __builtin_amdgcn_rsqf(s[1] * (1.f / D) + EPS), __builtin_amdgcn_rsqf(s[2] * (1.f / D) + EPS), __builtin_amdgcn_rsqf(s[3] * (1.f / D) + EPS)}; } }
#pragma unroll
        for (int ai = 0; ai < 2; ++ai)
#pragma unroll
            for (int m = 0; m < 4; ++m) { bf16_t* rowp = base + (size_t)(row0 + ai * 128 + m * 16) * ld + col0;
                const float rs = tr ? 1.f : __builtin_amdgcn_rsqf(SS[row0 + ai * 128 + m * 16] * (1.f / D) + EPS);
#pragma unroll
                for (int bj = 0; bj < 2; ++bj) { f32x4 v0 = acc[ai][bj][m][0] * rt[bj][0] * rs, v1 = acc[ai][bj][m][1] * rt[bj][1] * rs;
                    if (act == 1) { v0 = v0 * 0.18033688011112042f; v1 = v1 * 0.18033688011112042f; }
                    else if (act == 2) { v0 = (f32x4){fsilu(v0[0]), fsilu(v0[1]), fsilu(v0[2]), fsilu(v0[3])}; v1 = (f32x4){fsilu(v1[0]), fsilu(v1[1]), fsilu(v1[2]), fsilu(v1[3])}; }
                    u32x4 w = {pk2(v0[0], v0[1]), pk2(v0[2], v0[3]), pk2(v1[0], v1[1]), pk2(v1[2], v1[3])}; *(u32x4*)(rowp + bj * 128) = w; } }
    }
};

DI void tr_load(const float* W, int N, int nblk, int item, int lane, f32x4 (&v)[8]) {
    const int kb = item / nblk, nb = item - kb * nblk, k0 = 64 * kb, n0 = 32 * nb, lr = lane >> 3, lc = (lane & 7) * 4;
#pragma unroll
    for (int i = 0; i < 8; ++i) v[i] = __builtin_nontemporal_load((const f32x4*)(W + (size_t)(k0 + 8 * i + lr) * N + n0 + lc));
}
DI void tr_store(const f32x4 (&v)[8], int K, int nblk, const float* gain, bf16_t* WT, int mapkind, LAS float* scr, int item, int lane) {
    const int kb = item / nblk, nb = item - kb * nblk, k0 = 64 * kb, n0 = 32 * nb, lr = lane >> 3, lc = (lane & 7) * 4;
    int r0 = n0;
    if (mapkind == 1) r0 = n0 < 4096 ? n0 : (n0 < 8192 ? n0 + 4096 : n0 - 4096);
#pragma unroll
    for (int i = 0; i < 8; ++i) { const float gv = gain ? gain[k0 + 8 * i + lr] : 1.f; LAS float* d = scr + (8 * i + lr) * 33 + lc; d[0] = v[i].x * gv; d[1] = v[i].y * gv; d[2] = v[i].z * gv; d[3] = v[i].w * gv; }
    asm volatile("s_waitcnt lgkmcnt(0)" ::: "memory");
    const int c = lane & 7;
#pragma unroll
    for (int j = 0; j < 4; ++j) { const int n = (lane >> 3) + 8 * j; const LAS float* s = scr + (8 * c) * 33 + n;
        u32x4 o; o.x = pk2(s[0 * 33], s[1 * 33]); o.y = pk2(s[2 * 33], s[3 * 33]); o.z = pk2(s[4 * 33], s[5 * 33]); o.w = pk2(s[6 * 33], s[7 * 33]);
        *(u32x4*)(WT + (size_t)(r0 + n) * K + k0 + 8 * c) = o; }
    asm volatile("s_waitcnt lgkmcnt(0)" ::: "memory");
}
DI void convert_matrix(LAS unsigned char* lds, const Params& p, int id, int wslot, int nslots, int lane, int wave) {
    const float* W; const float* gain = nullptr; bf16_t* WT; int K, N, mapkind = 0;
    unsigned char* ws = p.ws;
    if (id < 2) { W = p.in[7] + (size_t)id * D * 12288; gain = p.in[6] + id * D; WT = (bf16_t*)(ws + OFF_WIN_A) + (size_t)id * 12288 * D; K = D; N = 12288; mapkind = 1; }
    else if (id < 4) { W = p.in[10] + (size_t)(id - 2) * EW * D; WT = (bf16_t*)(ws + OFF_WOUT_A) + (size_t)(id - 2) * D * EW; K = EW; N = D; }
    else if (id == 4) { W = p.in[12]; gain = p.in[11]; WT = (bf16_t*)(ws + OFF_WKV); K = D; N = 1024; }
    else if (id < 7) { W = p.in[14] + (size_t)(id - 5) * D * 8192; gain = p.in[13] + (id - 5) * D; WT = (bf16_t*)(ws + OFF_WIN_B) + (size_t)(id - 5) * 8192 * D; K = D; N = 8192; }
    else { W = p.in[16] + (size_t)(id - 7) * EW * D; WT = (bf16_t*)(ws + OFF_WOUT_B) + (size_t)(id - 7) * D * EW; K = EW; N = D; }
    const int nitems = (K / 64) * (N / 32);
    LAS float* scr = (LAS float*)(lds + wave * 8448);
    const int nblk = N / 32;
    f32x4 va[8], vb[8];
    int it = wslot;
    if (it < nitems) tr_load(W, N, nblk, it, lane, va);
    while (it < nitems) {
        const int it2 = it + nslots;
        if (it2 < nitems) tr_load(W, N, nblk, it2, lane, vb);
        tr_store(va, K, nblk, gain, WT, mapkind, scr, it, lane);
        if (it2 >= nitems) break;
        const int it3 = it2 + nslots;
        if (it3 < nitems) tr_load(W, N, nblk, it3, lane, va);
        tr_store(vb, K, nblk, gain, WT, mapkind, scr, it2, lane);
        it = it3;
    }
}
DI void convert_set(LAS unsigned char* lds, const Params& p, int set, int wslot, int nslots, int lane, int wave) {
    if (set == 0) convert_matrix(lds, p, 0, wslot, nslots, lane, wave);
    else if (set == 1) { convert_matrix(lds, p, 2, wslot, nslots, lane, wave); convert_matrix(lds, p, 3, wslot, nslots, lane, wave); convert_matrix(lds, p, 1, wslot, nslots, lane, wave); }
    else { for (int id = 4; id < 9; ++id) convert_matrix(lds, p, id, wslot, nslots, lane, wave); }
}

DI void norm_row(const float* src, float* xcopy, bf16_t* xb, float* y, const float* gain, int lane, float* ssout = nullptr) {
    const f32x4* xr = (const f32x4*)src + lane;
    f32x4 v[8]; float s = 0.f;
#pragma unroll
    for (int j = 0; j < 8; ++j) { v[j] = xr[64 * j]; s += (v[j].x * v[j].x + v[j].y * v[j].y) + (v[j].z * v[j].z + v[j].w * v[j].w); }
    const float tot = wave_sum(s);
    float rstd = __builtin_amdgcn_rsqf(tot * (1.f / D) + EPS);
    if (ssout) { if (lane == 0) *ssout = tot; rstd = 1.f; }
    if (xcopy) { f32x4* xc = (f32x4*)xcopy + lane;
#pragma unroll
        for (int j = 0; j < 8; ++j) xc[64 * j] = v[j]; }
    if (xb) { u32x2* o = (u32x2*)xb + lane;
#pragma unroll
        for (int j = 0; j < 8; ++j) { u32x2 w = {pk2(v[j].x * rstd, v[j].y * rstd), pk2(v[j].z * rstd, v[j].w * rstd)}; o[64 * j] = w; } }
    if (y) { f32x4* o = (f32x4*)y + lane; const f32x4* gr = (const f32x4*)gain + lane;
#pragma unroll
        for (int j = 0; j < 8; ++j) { const f32x4 gg = gr[64 * j]; o[64 * j] = v[j] * rstd * gg; } }
}

constexpr int S2_PBUF = 27648, S2_KE = 8448, S2_KET = 16896, S2_EL = 27136;
constexpr int S2_V = 55296, S2_OT = 88064, S2_ON = 154624;
DI void scan_phase(LAS unsigned char* lds, const Params& p, int layer, bool do_conv, const bf16_t* Qb, const bf16_t* Kb, const float* LF, const bf16_t* VT, const bf16_t* Gb, bf16_t* OG) {
    int tid = threadIdx.x; asm volatile("" : "+v"(tid));
    const int lane = tid & 63, w = __builtin_amdgcn_readfirstlane(tid >> 6), c = lane & 15, g = lane >> 4;
    const int G = gridDim.x, bid = blockIdx.x;
    int first, stride;
    if (G >= 128) { if (bid < 64) { first = bid; stride = 1 << 20; } else { first = 64 + (bid - 64); stride = G - 64; } } else { first = bid; stride = G; }
    if (tid < 256) ((LAS float*)(lds + S2_ON))[tid] = p.in[9][layer * 256 + tid];
    if (w < 4) {
    for (int item = first; item < 576; item += stride) {
        const bool isP = item < 64;
        int b, h, rowbase, ntok;
        if (isP) { b = item >> 4; h = item & 15; rowbase = b * TP; ntok = TP; } else { const int s = item - 64; b = s >> 4; h = s & 15; rowbase = NPR + b * 8; ntok = 8; }
        const int nsteps = (ntok + 31) >> 5;
            const int cw = w;
            f32x4 S[8][4];
            if (isP) {
#pragma unroll
                for (int i = 0; i < 8; ++i)
#pragma unroll
                    for (int dvt = 0; dvt < 4; ++dvt) S[i][dvt] = (f32x4){0.f, 0.f, 0.f, 0.f};
            } else {
                const float* sp = p.in[2] + (size_t)((layer * 32 + b) * 16 + h) * 32768 + 64 * cw + c;
#pragma unroll
                for (int i = 0; i < 8; ++i)
#pragma unroll
                    for (int dvt = 0; dvt < 4; ++dvt)
#pragma unroll
                        for (int j = 0; j < 4; ++j) S[i][dvt][j] = sp[(size_t)(16 * i + 4 * g + j) * 256 + 16 * dvt];
            }
            const int niter = (nsteps + 3) & ~1;
            for (int it = 0; it < niter; ++it) {
                if (it >= 1 && it <= nsteps) {
                    const int par = (it - 1) & 1;
                    LAS unsigned char* pbuf = lds + par * S2_PBUF;
                    LAS unsigned char* vbuf = lds + S2_V + par * 16384;
                    LAS float* OT = (LAS float*)(lds + S2_OT + par * 33280);
                    const int swz = (c >> 2) & 3;
                    f32x4 a00 = {0.f, 0.f, 0.f, 0.f}, a01 = a00, a11 = a00;
#pragma unroll
                    for (int kk = 0; kk < 4; ++kk) {
                        bf16x8 qe[2], ke[2];
#pragma unroll
                        for (int mt = 0; mt < 2; ++mt) {
                            const int off = (16 * mt + c) * 264 + (32 * kk + 4 * g) * 2;
                            const u32x2 q0 = *(const LAS u32x2*)(pbuf + off), q1 = *(const LAS u32x2*)(pbuf + off + 32);
                            const u32x2 k0 = *(const LAS u32x2*)(pbuf + S2_KE + off), k1 = *(const LAS u32x2*)(pbuf + S2_KE + off + 32);
                            qe[mt] = __builtin_bit_cast(bf16x8, (u32x4){q0.x, q0.y, q1.x, q1.y});
                            ke[mt] = __builtin_bit_cast(bf16x8, (u32x4){k0.x, k0.y, k1.x, k1.y});
                        }
                        a00 = __builtin_amdgcn_mfma_f32_16x16x32_bf16(ke[0], qe[0], a00, 0, 0, 0);
                        a01 = __builtin_amdgcn_mfma_f32_16x16x32_bf16(ke[0], qe[1], a01, 0, 0, 0);
                        a11 = __builtin_amdgcn_mfma_f32_16x16x32_bf16(ke[1], qe[1], a11, 0, 0, 0);
                    }
#pragma unroll
                    for (int j = 0; j < 4; ++j) { const bool keep = (4 * g + j) <= c; a00[j] = keep ? a00[j] : 0.f; a11[j] = keep ? a11[j] : 0.f; }
                    const bf16x8 pa0 = __builtin_bit_cast(bf16x8, (u32x4){pk2(a00[0], a00[1]), pk2(a00[2], a00[3]), 0u, 0u});
                    const bf16x8 pa1 = __builtin_bit_cast(bf16x8, (u32x4){pk2(a01[0], a01[1]), pk2(a01[2], a01[3]), pk2(a11[0], a11[1]), pk2(a11[2], a11[3])});
                    __builtin_amdgcn_sched_barrier(0);
#pragma unroll
                    for (int dh = 0; dh < 2; ++dh) {
                        bf16x8 vreg[2];
#pragma unroll
                        for (int d = 0; d < 2; ++d) {
                            const int row = 64 * cw + 16 * (2 * dh + d) + c;
                            const u32x2 a = *(const LAS u32x2*)(vbuf + row * 64 + ((g ^ swz) * 8)), bq = *(const LAS u32x2*)(vbuf + row * 64 + (((4 + g) ^ swz) * 8));
                            vreg[d] = __builtin_bit_cast(bf16x8, (u32x4){a.x, a.y, bq.x, bq.y});
                        }
                        f32x4 o[2][2];
#pragma unroll
                        for (int mt = 0; mt < 2; ++mt) { o[mt][0] = (f32x4){0.f, 0.f, 0.f, 0.f}; o[mt][1] = (f32x4){0.f, 0.f, 0.f, 0.f}; }
#pragma unroll
                        for (int kk = 0; kk < 4; ++kk) {
                            bf16x8 qe[2];
#pragma unroll
                            for (int mt = 0; mt < 2; ++mt) {
                                const int off = (16 * mt + c) * 264 + (32 * kk + 4 * g) * 2;
                                const u32x2 q0 = *(const LAS u32x2*)(pbuf + off), q1 = *(const LAS u32x2*)(pbuf + off + 32);
                                qe[mt] = __builtin_bit_cast(bf16x8, (u32x4){q0.x, q0.y, q1.x, q1.y});
                            }
#pragma unroll
                            for (int d = 0; d < 2; ++d) {
                                const f32x4 s0 = S[2 * kk][2 * dh + d], s1 = S[2 * kk + 1][2 * dh + d];
                                const bf16x8 sb = __builtin_bit_cast(bf16x8, (u32x4){pk2(s0[0], s0[1]), pk2(s0[2], s0[3]), pk2(s1[0], s1[1]), pk2(s1[2], s1[3])});
                                o[0][d] = __builtin_amdgcn_mfma_f32_16x16x32_bf16(qe[0], sb, o[0][d], 0, 0, 0);
                                o[1][d] = __builtin_amdgcn_mfma_f32_16x16x32_bf16(qe[1], sb, o[1][d], 0, 0, 0);
                            }
                        }
#pragma unroll
                        for (int d = 0; d < 2; ++d) {
                            o[0][d] = __builtin_amdgcn_mfma_f32_16x16x32_bf16(pa0, vreg[d], o[0][d], 0, 0, 0);
                            o[1][d] = __builtin_amdgcn_mfma_f32_16x16x32_bf16(pa1, vreg[d], o[1][d], 0, 0, 0);
                        }
#pragma unroll
                        for (int i = 0; i < 8; ++i) {
                            const u32x2 t0 = *(const LAS u32x2*)(pbuf + S2_KET + (16 * i + c) * 80 + 8 * g), t1 = *(const LAS u32x2*)(pbuf + S2_KET + (16 * i + c) * 80 + 32 + 8 * g);
                            const bf16x8 kt = __builtin_bit_cast(bf16x8, (u32x4){t0.x, t0.y, t1.x, t1.y});
                            const f32x4 el = *(const LAS f32x4*)(pbuf + S2_EL + (16 * i + 4 * g) * 4);
#pragma unroll
                            for (int d = 0; d < 2; ++d) { S[i][2 * dh + d] = __builtin_amdgcn_mfma_f32_16x16x32_bf16(kt, vreg[d], S[i][2 * dh + d], 0, 0, 0); S[i][2 * dh + d] = S[i][2 * dh + d] * el; }
                        }
#pragma unroll
                        for (int mt = 0; mt < 2; ++mt)
#pragma unroll
                            for (int d = 0; d < 2; ++d)
#pragma unroll
                                for (int j = 0; j < 4; ++j) OT[(16 * mt + 4 * g + j) * 260 + 64 * cw + 16 * (2 * dh + d) + c] = o[mt][d][j];
                        __builtin_amdgcn_sched_barrier(0);
                    }
                }
                lds_barrier();
            }
            {
                float* sp = p.out + (isP ? O_SP + (size_t)((layer * 4 + b) * 16 + h) * 32768 : O_SS + (size_t)((layer * 32 + b) * 16 + h) * 32768) + 64 * cw + c;
#pragma unroll
                for (int i = 0; i < 8; ++i)
#pragma unroll
                    for (int dvt = 0; dvt < 4; ++dvt)
#pragma unroll
                        for (int j = 0; j < 4; ++j) sp[(size_t)(16 * i + 4 * g + j) * 256 + 16 * dvt] = S[i][dvt][j];
            }
    }
    } else {
    for (int item = first; item < 576; item += stride) {
        const bool isP = item < 64;
        int b, h, rowbase, ntok;
        if (isP) { b = item >> 4; h = item & 15; rowbase = b * TP; ntok = TP; } else { const int s = item - 64; b = s >> 4; h = s & 15; rowbase = NPR + b * 8; ntok = 8; }
        const int nsteps = (ntok + 31) >> 5;
            const int pw = w - 4, pt = tid - 256;
            const int ch0 = 2 * (16 * pw + c), tg = g;
            const int ntk = pt >> 3, nsg = pt & 7;
            f32x2 Rlf[2][8]; unsigned Rq[2][8], Rk[2][8]; u32x4 Rv[2][4]; u32x2 Rg[2][8];
            const int niter = (nsteps + 3) & ~1;
#pragma unroll
            for (int hf = 0; hf < 2; ++hf) {
                const int pc = hf < nsteps - 1 ? hf : nsteps - 1;
                const size_t o = (size_t)(rowbase + 32 * pc + 8 * tg) * D + h * 128 + ch0;
#pragma unroll
                for (int i = 0; i < 8; ++i) { Rlf[hf][i] = *(const f32x2*)(LF + o + (size_t)i * D); Rq[hf][i] = *(const unsigned*)(Qb + o + (size_t)i * D); Rk[hf][i] = *(const unsigned*)(Kb + o + (size_t)i * D); }
                const bf16_t* vp = VT + (size_t)(h * 256 + pt) * MP + rowbase + 32 * pc;
#pragma unroll
                for (int q = 0; q < 4; ++q) Rv[hf][q] = *(const u32x4*)(vp + 8 * q);
#pragma unroll
                for (int e = 0; e < 8; ++e) Rg[hf][e] = (u32x2){0u, 0u};
            }
            for (int it0 = 0; it0 < niter; it0 += 2) {
#pragma unroll
                for (int hf = 0; hf < 2; ++hf) {
                    const int it = it0 + hf;
                    {
                        const int pc = it < nsteps - 1 ? it : nsteps - 1;
                        const int tok0 = 32 * pc, nvalid = (ntok - tok0) < 32 ? (ntok - tok0) : 32;
                        LAS unsigned char* pbuf = lds + hf * S2_PBUF;
                        LAS unsigned char* vbuf = lds + S2_V + hf * 16384;
                        {
                            const int nc = it >= 2 ? it - 2 : 0;
                            const int ntok0 = 32 * nc; int nvn = (ntok - ntok0) < 32 ? (ntok - ntok0) : 32; if (it < 2 || nc >= nsteps) nvn = 0;
                            const LAS float* OT = (const LAS float*)(lds + S2_OT + hf * 33280);
                            f32x4 ov[8]; float ss = 0.f;
#pragma unroll
                            for (int e = 0; e < 8; ++e) { ov[e] = *(const LAS f32x4*)(OT + ntk * 260 + 4 * nsg + 32 * e); ss += (ov[e].x * ov[e].x + ov[e].y * ov[e].y) + (ov[e].z * ov[e].z + ov[e].w * ov[e].w); }
                            ss += __shfl_xor(ss, 1); ss += __shfl_xor(ss, 2); ss += __shfl_xor(ss, 4);
                            const float rstd = __builtin_amdgcn_rsqf(ss * (1.f / 256.f) + EPS);
                            const int orow = ntk < nvn ? rowbase + ntok0 + ntk : MT + ntk;
                            const size_t ro = (size_t)orow * EW + h * 256 + 4 * nsg;
#pragma unroll
                            for (int e = 0; e < 8; ++e) {
                                const u32x2 gg = Rg[hf][e];
                                u32x2 wv = {pk2(ov[e].x * rstd * bflo(gg.x), ov[e].y * rstd * bfhi(gg.x)), pk2(ov[e].z * rstd * bflo(gg.y), ov[e].w * rstd * bfhi(gg.y))};
                                *(u32x2*)(OG + ro + 32 * e) = wv;
                            }
                        }
                        {
                            const size_t ro = (size_t)(rowbase + tok0 + ntk) * EW + h * 256 + 4 * nsg;
#pragma unroll
                            for (int e = 0; e < 8; ++e) Rg[hf][e] = *(const u32x2*)(Gb + ro + 32 * e);
                        }
                        float cs[8][2], kv[8][2], qv[8][2]; float r0 = 0.f, r1 = 0.f;
                        if (nvalid >= 32) {
#pragma unroll
                            for (int i = 0; i < 8; ++i) { r0 += Rlf[hf][i].x; r1 += Rlf[hf][i].y; cs[i][0] = r0; cs[i][1] = r1; kv[i][0] = bflo(Rk[hf][i]); kv[i][1] = bfhi(Rk[hf][i]); }
                        } else {
#pragma unroll
                            for (int i = 0; i < 8; ++i) { const bool ok = (8 * tg + i) < nvalid; r0 += ok ? Rlf[hf][i].x : 0.f; r1 += ok ? Rlf[hf][i].y : 0.f; cs[i][0] = r0; cs[i][1] = r1;
                                kv[i][0] = ok ? bflo(Rk[hf][i]) : 0.f; kv[i][1] = ok ? bfhi(Rk[hf][i]) : 0.f; }
                        }
#pragma unroll
                        for (int i = 0; i < 8; ++i) { qv[i][0] = bflo(Rq[hf][i]); qv[i][1] = bfhi(Rq[hf][i]); }
                        {
                            const int swz = (pt >> 2) & 3;
#pragma unroll
                            for (int q = 0; q < 4; ++q) {
                                const u32x4 v = Rv[hf][q];
                                *(LAS u32x2*)(vbuf + pt * 64 + (((2 * q) ^ swz) * 8)) = (u32x2){v.x, v.y};
                                *(LAS u32x2*)(vbuf + pt * 64 + (((2 * q + 1) ^ swz) * 8)) = (u32x2){v.z, v.w};
                            }
                        }
                        {
                            const int nc2 = (it + 2) < nsteps - 1 ? (it + 2) : nsteps - 1;
                            const size_t o = (size_t)(rowbase + 32 * nc2 + 8 * tg) * D + h * 128 + ch0;
#pragma unroll
                            for (int i = 0; i < 8; ++i) { Rlf[hf][i] = *(const f32x2*)(LF + o + (size_t)i * D); Rq[hf][i] = *(const unsigned*)(Qb + o + (size_t)i * D); Rk[hf][i] = *(const unsigned*)(Kb + o + (size_t)i * D); }
                            const bf16_t* vp = VT + (size_t)(h * 256 + pt) * MP + rowbase + 32 * nc2;
#pragma unroll
                            for (int q = 0; q < 4; ++q) Rv[hf][q] = *(const u32x4*)(vp + 8 * q);
                        }
                        float i0 = r0, i1 = r1;
                        { const float t0 = __shfl_up(i0, 16), t1 = __shfl_up(i1, 16); if (tg >= 1) { i0 += t0; i1 += t1; } }
                        { const float t0 = __shfl_up(i0, 32), t1 = __shfl_up(i1, 32); if (tg >= 2) { i0 += t0; i1 += t1; } }
                        const float last0 = __shfl(i0, 48 + c), last1 = __shfl(i1, 48 + c);
                        const float e0 = i0 - r0, e1 = i1 - r1;
                        unsigned ka[8];
#pragma unroll
                        for (int i = 0; i < 8; ++i) {
                            const float c0 = e0 + cs[i][0], c1 = e1 + cs[i][1];
                            const unsigned qp = pk2(qv[i][0] * __builtin_amdgcn_exp2f(c0), qv[i][1] * __builtin_amdgcn_exp2f(c1));
                            const unsigned kp = pk2(kv[i][0] * __builtin_amdgcn_exp2f(-c0), kv[i][1] * __builtin_amdgcn_exp2f(-c1));
                            *(LAS unsigned*)(pbuf + (8 * tg + i) * 264 + ch0 * 2) = qp;
                            *(LAS unsigned*)(pbuf + S2_KE + (8 * tg + i) * 264 + ch0 * 2) = kp;
                            ka[i] = kp;
                        }
                        *(LAS u32x4*)(pbuf + S2_KET + ch0 * 80 + 16 * tg) = (u32x4){__builtin_amdgcn_perm(ka[1], ka[0], 0x05040100u), __builtin_amdgcn_perm(ka[3], ka[2], 0x05040100u), __builtin_amdgcn_perm(ka[5], ka[4], 0x05040100u), __builtin_amdgcn_perm(ka[7], ka[6], 0x05040100u)};
                        *(LAS u32x4*)(pbuf + S2_KET + (ch0 + 1) * 80 + 16 * tg) = (u32x4){__builtin_amdgcn_perm(ka[1], ka[0], 0x07060302u), __builtin_amdgcn_perm(ka[3], ka[2], 0x07060302u), __builtin_amdgcn_perm(ka[5], ka[4], 0x07060302u), __builtin_amdgcn_perm(ka[7], ka[6], 0x07060302u)};
                        if (tg == 0) { *(LAS float*)(pbuf + S2_EL + ch0 * 4) = __builtin_amdgcn_exp2f(last0); *(LAS float*)(pbuf + S2_EL + ch0 * 4 + 4) = __builtin_amdgcn_exp2f(last1); }
                        lds_barrier();
                    }
                }
            }
    }
    }
    {
        int wslot = -1, nslots = 0;
        if (G >= 128) { if (bid >= 64) { wslot = (bid - 64) * 8 + w; nslots = (G - 64) * 8; } } else { wslot = bid * 8 + w; nslots = G * 8; }
        if (wslot >= 0 && do_conv) {
            __syncthreads(); convert_set(lds, p, layer + 1, wslot, nslots, lane, w);
            if (layer == 0) {
                float* X = (float*)(p.ws + OFF_X);
                for (int m = wslot; m < MT; m += nslots) {
                    const float* srow;
                    if (m < NPR) { const int bb = m / TP, t = m - bb * TP; srow = t < 16 ? p.in[5] + (size_t)t * D : p.in[0] + (size_t)(bb * 2048 + t - 16) * D; }
                    else srow = p.in[1] + (size_t)(m - NPR) * D;
                    const f32x4* s4 = (const f32x4*)srow + lane; f32x4* d4 = (f32x4*)(X + (size_t)m * D) + lane;
                    f32x4 v[8];
#pragma unroll
                    for (int j = 0; j < 8; ++j) v[j] = s4[64 * j];
#pragma unroll
                    for (int j = 0; j < 8; ++j) d4[64 * j] = v[j];
                }
                for (int i = wslot * 64 + lane; i < 32 * 120 * 128; i += nslots * 64) { const int bs = i / (120 * 128), r = i - bs * (120 * 128);
                    ((f32x4*)(p.out + O_CKS))[(size_t)bs * 128 * 128 + r] = ((const f32x4*)p.in[3])[(size_t)bs * 128 * 128 + 8 * 128 + r];
                    ((f32x4*)(p.out + O_CVS))[(size_t)bs * 128 * 128 + r] = ((const f32x4*)p.in[4])[(size_t)bs * 128 * 128 + 8 * 128 + r]; }
            }
        }
    }
}

constexpr int AT_K = 0, AT_V = 23040;
template <bool PRE>
DI void attn_compute(LAS unsigned char* lds, const bf16_t* QA, const bf16_t* GA, bf16_t* OA, bool isP, int t0, int qrowbase, int hh, float slope, float sink, int c, int g,
                     const bf16x8 (&qpre)[2][2], const u32x2 (&gpre)[2][4]) {
#pragma unroll
    for (int qt = 0; qt < 2; ++qt) {
        bf16x8 qf[2];
#pragma unroll
        for (int kk = 0; kk < 2; ++kk) qf[kk] = PRE ? qpre[qt][kk] : *(const bf16x8*)(QA + (size_t)(qrowbase + 16 * qt + c) * EW + hh * 64 + 32 * kk + 8 * g);
        f32x4 sT[10];
#pragma unroll
        for (int kt = 0; kt < 10; ++kt) {
            if (kt == (qt == 0 ? 9 : 0)) { sT[kt] = (f32x4){0.f, 0.f, 0.f, 0.f}; continue; }
            const bf16x8 k0 = *(const LAS bf16x8*)(lds + AT_K + (16 * kt + c) * 144 + 16 * g), k1 = *(const LAS bf16x8*)(lds + AT_K + (16 * kt + c) * 144 + 64 + 16 * g);
            f32x4 a = {0.f, 0.f, 0.f, 0.f};
            a = __builtin_amdgcn_mfma_f32_16x16x32_bf16(k0, qf[0], a, 0, 0, 0); a = __builtin_amdgcn_mfma_f32_16x16x32_bf16(k1, qf[1], a, 0, 0, 0); sT[kt] = a;
            if (kt & 1) __builtin_amdgcn_sched_barrier(0);
        }
        float m = -1e30f;
        const int dbase = 128 + 16 * qt + c - 4 * g;
        const int kmin = isP ? (128 - t0 - 4 * g) : -1000;
        const float sb = slope * (float)dbase;
        if (!isP || t0 >= 128) {
#pragma unroll
            for (int kt = 0; kt < 10; ++kt) {
                if (kt == (qt == 0 ? 9 : 0)) continue;
                const bool inner = (kt >= 1 + qt) && (kt <= 7 + qt);
#pragma unroll
                for (int j = 0; j < 4; ++j) { const int cst = 16 * kt + j; const int dist = dbase - cst;
                    const bool valid = inner ? true : ((unsigned)dist < 128u);
                    const float x = valid ? (sT[kt][j] - sb) + slope * (float)cst : -1e30f; sT[kt][j] = x; m = fmaxf(m, x); }
            }
        } else {
#pragma unroll
            for (int kt = 0; kt < 10; ++kt) {
                if (kt == (qt == 0 ? 9 : 0)) continue;
#pragma unroll
                for (int j = 0; j < 4; ++j) { const int cst = 16 * kt + j; const int dist = dbase - cst;
                    const bool valid = ((unsigned)dist < 128u) && (cst >= kmin);
                    const float x = valid ? (sT[kt][j] - sb) + slope * (float)cst : -1e30f; sT[kt][j] = x; m = fmaxf(m, x); }
            }
        }
        m = fmaxf(m, __shfl_xor(m, 16)); m = fmaxf(m, __shfl_xor(m, 32)); m = fmaxf(m, sink);
        float l = 0.f;
#pragma unroll
        for (int kt = 0; kt < 10; ++kt) {
            if (kt == (qt == 0 ? 9 : 0)) continue;
#pragma unroll
            for (int j = 0; j < 4; ++j) { const float pv = __builtin_amdgcn_exp2f(sT[kt][j] - m); sT[kt][j] = pv; l += pv; }
        }
        l += __shfl_xor(l, 16); l += __shfl_xor(l, 32); l += __builtin_amdgcn_exp2f(sink - m);
        const float inv = 1.f / l;
        f32x4 oT[4];
#pragma unroll
        for (int dt = 0; dt < 4; ++dt) oT[dt] = (f32x4){0.f, 0.f, 0.f, 0.f};
#pragma unroll
        for (int ks = 0; ks < 5; ++ks) {
            const f32x4 s0 = sT[2 * ks], s1 = sT[2 * ks + 1];
            const bf16x8 pb = __builtin_bit_cast(bf16x8, (u32x4){pk2(s0[0], s0[1]), pk2(s0[2], s0[3]), pk2(s1[0], s1[1]), pk2(s1[2], s1[3])});
#pragma unroll
            for (int dt = 0; dt < 4; ++dt) {
                const u32x2 v0 = *(const LAS u32x2*)(lds + AT_V + (16 * dt + c) * 336 + (32 * ks + 4 * g) * 2), v1 = *(const LAS u32x2*)(lds + AT_V + (16 * dt + c) * 336 + (32 * ks + 16 + 4 * g) * 2);
                const bf16x8 vf = __builtin_bit_cast(bf16x8, (u32x4){v0.x, v0.y, v1.x, v1.y});
                oT[dt] = __builtin_amdgcn_mfma_f32_16x16x32_bf16(vf, pb, oT[dt], 0, 0, 0);
            }
            __builtin_amdgcn_sched_barrier(0);
        }
        const int qidx = 16 * qt + c; const bool ok = isP ? (t0 + qidx < TP) : (qidx < 8);
        if (ok) {
            const size_t ro = (size_t)(qrowbase + qidx) * EW + hh * 64 + 4 * g;
#pragma unroll
            for (int dt = 0; dt < 4; ++dt) { const u32x2 gt = PRE ? gpre[qt][dt] : *(const u32x2*)(GA + ro + 16 * dt); const f32x4 ov = oT[dt] * inv;
                u32x2 wv = {pk2(ov[0] * bflo(gt.x), ov[1] * bfhi(gt.x)), pk2(ov[2] * bflo(gt.y), ov[3] * bfhi(gt.y))}; *(u32x2*)(OA + ro + 16 * dt) = wv; }
        }
        __builtin_amdgcn_sched_barrier(0);
    }
}

DI void attn_kv_load(const bf16_t* KS, const bf16_t* VTS, int u, int tid, u32x4 (&kr)[3], u32x4 (&vr)[3]) {
    const int b = u / 520, rem = u - b * 520, kvh = rem / 65, t0 = 32 * (rem - kvh * 65);
#pragma unroll
    for (int r = 0; r < 3; ++r) {
        int q = tid + 512 * r; q = q < 1280 ? q : 1279;
        const int key = q >> 3, part = q & 7; int s = t0 - 128 + key; s = s < 0 ? 0 : s;
        kr[r] = *(const u32x4*)(KS + (size_t)(b * TP + s) * 512 + kvh * 64 + part * 8);
        const int d = q / 20, chn = q - d * 20; int s0 = t0 - 128 + 8 * chn; s0 = s0 < 0 ? 0 : s0;
        vr[r] = *(const u32x4*)(VTS + (size_t)(kvh * 64 + d) * MP + b * TP + s0);
    }
}
DI void attn_kv_store(LAS unsigned char* lds, int u, int tid, const u32x4 (&kr)[3], const u32x4 (&vr)[3]) {
    const int b = u / 520, rem = u - b * 520, kvh = rem / 65, t0 = 32 * (rem - kvh * 65);
#pragma unroll
    for (int r = 0; r < 3; ++r) {
        const int q = tid + 512 * r;
        if (q < 1280) {
            const int key = q >> 3, part = q & 7, s = t0 - 128 + key;
            *(LAS u32x4*)(lds + AT_K + key * 144 + part * 16) = s >= 0 ? kr[r] : (u32x4){0u, 0u, 0u, 0u};
            const int d = q / 20, chn = q - d * 20, s0 = t0 - 128 + 8 * chn;
            *(LAS u32x4*)(lds + AT_V + d * 336 + chn * 16) = s0 >= 0 ? vr[r] : (u32x4){0u, 0u, 0u, 0u};
        }
    }
}

DI void attn_phase(LAS unsigned char* lds, const Params& p, int layer, const bf16_t* QA, const bf16_t* KS, const bf16_t* VTS, const bf16_t* GA, bf16_t* OA) {
    int tid = threadIdx.x; asm volatile("" : "+v"(tid));
    const int lane = tid & 63, w = __builtin_amdgcn_readfirstlane(tid >> 6), c = lane & 15, g = lane >> 4;
    const int G = gridDim.x;
    {
        u32x4 kr[3], vr[3];
        int u = blockIdx.x;
        if (u < 2080) attn_kv_load(KS, VTS, u, tid, kr, vr);
        for (; u < 2080; u += G) {
            const int b = u / 520, rem = u - b * 520, kvh = rem / 65, t0 = 32 * (rem - kvh * 65), qrowbase = b * TP + t0;
            const int hh = kvh * 8 + w;
            bf16x8 qpre[2][2]; u32x2 gpre[2][4];
#pragma unroll
            for (int qt = 0; qt < 2; ++qt) {
#pragma unroll
                for (int kk = 0; kk < 2; ++kk) qpre[qt][kk] = *(const bf16x8*)(QA + (size_t)(qrowbase + 16 * qt + c) * EW + hh * 64 + 32 * kk + 8 * g);
#pragma unroll
                for (int dt = 0; dt < 4; ++dt) gpre[qt][dt] = *(const u32x2*)(GA + (size_t)(qrowbase + 16 * qt + c) * EW + hh * 64 + 4 * g + 16 * dt);
            }
            lds_barrier();
            attn_kv_store(lds, u, tid, kr, vr);
            const int un = (u + G) < 2080 ? (u + G) : u;
            attn_kv_load(KS, VTS, un, tid, kr, vr);
            lds_barrier();
            const float slope = exp2f(-(float)(hh + 1) * 0.125f) * 1.4426950408889634f, sink = p.in[15][layer * 64 + hh] * 1.4426950408889634f;
            attn_compute<true>(lds, QA, GA, OA, true, t0, qrowbase, hh, slope, sink, c, g, qpre, gpre);
        }
    }
    for (int u = 2080 + blockIdx.x; u < 2336; u += G) {
        const int s = u - 2080, b = s >> 3, kvh = s & 7, qrowbase = NPR + 8 * b;
        __syncthreads();
        {
            const float* ck = p.in[3]; const float* cv = p.in[4];
            for (int q = tid; q < 1280; q += 512) {
                const int key = q >> 3, part = q & 7;
                u32x4 v = {0u, 0u, 0u, 0u};
                if (key < 128) { const f32x4* src = (const f32x4*)(ck + (size_t)((b * 128 + key) * 8 + kvh) * 64 + part * 8); const f32x4 x0 = src[0], x1 = src[1];
                    v = (u32x4){pk2(x0.x, x0.y), pk2(x0.z, x0.w), pk2(x1.x, x1.y), pk2(x1.z, x1.w)}; }
                else if (key < 136) v = *(const u32x4*)(KS + (size_t)(NPR + 8 * b + key - 128) * 512 + kvh * 64 + part * 8);
                *(LAS u32x4*)(lds + AT_K + key * 144 + part * 16) = v;
            }
            for (int q = tid; q < 1280; q += 512) {
                const int d = q & 63, chn = q >> 6;
                u32x4 v = {0u, 0u, 0u, 0u};
                if (chn < 16) { float x[8];
#pragma unroll
                    for (int e = 0; e < 8; ++e) x[e] = cv[(size_t)((b * 128 + 8 * chn + e) * 8 + kvh) * 64 + d];
                    v = (u32x4){pk2(x[0], x[1]), pk2(x[2], x[3]), pk2(x[4], x[5]), pk2(x[6], x[7])}; }
                else if (chn == 16) v = *(const u32x4*)(VTS + (size_t)(kvh * 64 + d) * MP + NPR + 8 * b);
                *(LAS u32x4*)(lds + AT_V + d * 336 + chn * 16) = v;
            }
        }
        __syncthreads();
        const int hh = kvh * 8 + w;
        const float slope = exp2f(-(float)(hh + 1) * 0.125f) * 1.4426950408889634f, sink = p.in[15][layer * 64 + hh] * 1.4426950408889634f;
        bf16x8 qd[2][2]; u32x2 gd[2][4];
#pragma unroll
        for (int qt = 0; qt < 2; ++qt) {
#pragma unroll
            for (int kk = 0; kk < 2; ++kk) qd[qt][kk] = (bf16x8){0, 0, 0, 0, 0, 0, 0, 0};
#pragma unroll
            for (int dt = 0; dt < 4; ++dt) gd[qt][dt] = (u32x2){0u, 0u};
        }
        attn_compute<false>(lds, QA, GA, OA, false, 0, qrowbase, hh, slope, sink, c, g, qd, gd);
    }
}

#define XB_TMO      128
#define XB_XCNT(j)  (256  + 64 * (j))
#define XB_XSUB(j)  (1280 + 64 * (j))
#define XB_XGEN(j)  (2304 + 64 * (j))
#define XB_TOP      3328
#define XB_TOPGEN   3392
#define XCD_BAR_WORDS 3456
#define XB_SPIN_CAP (1u << 18)

__device__ __forceinline__ unsigned xb_ld(unsigned* p)              { return __hip_atomic_load(p, __ATOMIC_RELAXED, __HIP_MEMORY_SCOPE_AGENT); }
__device__ __forceinline__ unsigned xb_add(unsigned* p, unsigned v) { return __hip_atomic_fetch_add(p, v, __ATOMIC_RELAXED, __HIP_MEMORY_SCOPE_AGENT); }
__device__ __forceinline__ unsigned xb_xcc_id() { return (unsigned)__builtin_amdgcn_s_getreg((3 << 11) | 20) & 0xFu; }
#define XB_SPIN(cond, bar) do { unsigned _sp = 0; while (cond) { __builtin_amdgcn_s_sleep(1); \
    if ((++_sp & 255u) == 0u) { if (xb_ld(&(bar)[XB_TMO])) break; if (_sp > XB_SPIN_CAP) { atomicAdd(&(bar)[XB_TMO], 1u); break; } } } } while (0)

struct XcdBarrier {
    unsigned* bar; unsigned x;
    volatile LAS unsigned* st;
};

__device__ __forceinline__ XcdBarrier xcd_barrier_post(unsigned* bar, volatile LAS unsigned* st) {
    XcdBarrier b; b.bar = bar; b.x = xb_xcc_id(); b.st = st;
    if (threadIdx.x == 0) (void)xb_add(&bar[XB_XCNT(b.x)], 1u);
    return b;
}
__device__ __forceinline__ void xcd_barrier_complete(unsigned* bar, unsigned x, unsigned& nloc, unsigned& nx) {
    const unsigned G = gridDim.x * gridDim.y * gridDim.z;
    unsigned sum, cnt, mine, sp = 0u;
    for (;;) {
        sum = 0u; cnt = 0u; mine = 0u;
#pragma unroll
        for (unsigned j = 0; j < 16; ++j) { const unsigned c = xb_ld(&bar[XB_XCNT(j)]); sum += c; cnt += (c > 0u) ? 1u : 0u; mine = (j == x) ? c : mine; }
        if (sum == G) break;
        __builtin_amdgcn_s_sleep(1);
        if ((++sp & 255u) == 0u) { if (xb_ld(&bar[XB_TMO])) break; if (sp > XB_SPIN_CAP) { atomicAdd(&bar[XB_TMO], 1u); break; } }
    }
    nloc = mine > 0u ? mine : 1u; nx = cnt > 0u ? cnt : 1u;
}

__device__ __forceinline__ void xcd_barrier(const XcdBarrier& b) {
    asm volatile("s_waitcnt vmcnt(0)" ::: "memory");
    __syncthreads();
    if (threadIdx.x == 0) {
        unsigned* bar = b.bar;
        __builtin_amdgcn_s_waitcnt(0);
        unsigned nloc = b.st[0], nx = b.st[1];
        if (nloc == 0u) { xcd_barrier_complete(bar, b.x, nloc, nx); b.st[0] = nloc; b.st[1] = nx; }
        const unsigned old = xb_add(&bar[XB_XSUB(b.x)], 1u);
        const unsigned gen = old / nloc;
        if (old + 1u == (gen + 1u) * nloc) {
            __builtin_amdgcn_fence(__ATOMIC_RELEASE, "agent");
            asm volatile("s_waitcnt vmcnt(0)" ::: "memory");
            const unsigned og = xb_add(&bar[XB_TOP], 1u);
            const unsigned tg = og / nx;
            if (og + 1u == (tg + 1u) * nx) xb_add(&bar[XB_TOPGEN], 1u);
            else XB_SPIN(xb_ld(&bar[XB_TOPGEN]) == tg, bar);
            __builtin_amdgcn_fence(__ATOMIC_ACQUIRE, "agent");
            xb_add(&bar[XB_XGEN(b.x)], 1u);
            asm volatile("s_waitcnt vmcnt(0)" ::: "memory");
        } else {
            XB_SPIN(xb_ld(&bar[XB_XGEN(b.x)]) == gen, bar);
            __builtin_amdgcn_fence(__ATOMIC_ACQUIRE, "agent");
            asm volatile("s_waitcnt vmcnt(0)" ::: "memory");
        }
    }
    __syncthreads();
}


DI void norm_phase(const Params& p, int mode) {
    int tid = threadIdx.x; asm volatile("" : "+v"(tid));
    const int lane = tid & 63, wave = __builtin_amdgcn_readfirstlane(tid >> 6);
    const int gw = blockIdx.x * 8 + wave, NGW = gridDim.x * 8;
    float* X = (float*)(p.ws + OFF_X); bf16_t* XB = (bf16_t*)(p.ws + OFF_XB);
    if (mode == 1) {
        const bf16_t* KS = (const bf16_t*)(p.ws + OFF_KS); const bf16_t* VTS = (const bf16_t*)(p.ws + OFF_VTS);
        const int gt = blockIdx.x * 512 + tid, NT = gridDim.x * 512;
        for (int i = gt; i < (512 + 256) * 512; i += NT) {
            const int r = i >> 9, col = i & 511;
            int row; size_t dk, dv;
            if (r < 512) { const int b = r >> 7, t = r & 127; row = b * TP + (TP - 128) + t; dk = O_CKP + (size_t)r * 512 + col; dv = O_CVP + (size_t)r * 512 + col; }
            else { const int s = r - 512; row = NPR + s; const size_t o = (size_t)((s >> 3) * 128 + 120 + (s & 7)) * 512 + col; dk = O_CKS + o; dv = O_CVS + o; }
            p.out[dk] = bf2f(KS[(size_t)row * 512 + col]);
            p.out[dv] = bf2f(VTS[(size_t)col * MP + row]);
        }
    }
    for (int m = gw; m < MT; m += NGW) {
        if (mode == 0) norm_row(X + (size_t)m * D, nullptr, XB + (size_t)m * D, nullptr, nullptr, lane);
        else if (mode == 1) {
            float* dst;
            if (m < NPR) { const int b = m / TP, t = m - b * TP; if (t < 16) continue; dst = p.out + O_YP + (size_t)(b * 2048 + t - 16) * D; }
            else dst = p.out + O_YS + (size_t)(m - NPR) * D;
            norm_row(X + (size_t)m * D, nullptr, nullptr, dst, p.in[17], lane);
        } else {
            const float* src;
            if (m < NPR) { const int b = m / TP, t = m - b * TP; src = t < 16 ? p.in[5] + (size_t)t * D : p.in[0] + (size_t)(b * 2048 + t - 16) * D; }
            else src = p.in[1] + (size_t)(m - NPR) * D;
            norm_row(src, nullptr, XB + (size_t)m * D, nullptr, nullptr, lane, (float*)(p.ws + OFF_SS) + m);
        }
    }
}

DI void reduce_phase(const Params& p, int ssidx) {
    int tid = threadIdx.x; asm volatile("" : "+v"(tid));
    const int lane = tid & 63, wave = __builtin_amdgcn_readfirstlane(tid >> 6);
    const int G = gridDim.x, NGW = G * 8;
    float* X = (float*)(p.ws + OFF_X); bf16_t* XB = (bf16_t*)(p.ws + OFF_XB); float* SS = (float*)(p.ws + OFF_SS) + (size_t)ssidx * MP; const float* P = (const float*)(p.ws + OFF_Q);
    for (int task = wave * G + (int)blockIdx.x; task < (MT - 8192) * 8; task += NGW) {
        const int r = 8192 + (task >> 3), j = task & 7;
        const int pmi = (r - 8192) >> 8, rr = (r - 8192) & 255;
        const float* pp = P + (size_t)((pmi * 8 + j) * 16) * 65536 + rr * 256 + lane * 4;
        f32x4 s = *(const f32x4*)(X + (size_t)r * D + j * 256 + lane * 4);
        f32x4 t[16];
#pragma unroll
        for (int kp = 0; kp < 16; ++kp) t[kp] = *(const f32x4*)(pp + (size_t)kp * 65536);
#pragma unroll
        for (int kp = 0; kp < 16; ++kp) s = s + t[kp];
        *(f32x4*)(X + (size_t)r * D + j * 256 + lane * 4) = s;
        *(u32x2*)(XB + (size_t)r * D + j * 256 + lane * 4) = (u32x2){pk2(s.x, s.y), pk2(s.z, s.w)};
        const float ss = wave_sum((s.x * s.x + s.y * s.y) + (s.z * s.z + s.w * s.w));
        if (lane == 0) __hip_atomic_fetch_add(SS + r, ss, __ATOMIC_RELAXED, __HIP_MEMORY_SCOPE_AGENT);
    }
}

DI void prologue_phase(LAS unsigned char* lds, const Params& p) {
    int tid = threadIdx.x; asm volatile("" : "+v"(tid));
    const int lane = tid & 63, wave = __builtin_amdgcn_readfirstlane(tid >> 6);
    const int G = gridDim.x, bid = blockIdx.x, gw = bid * 8 + wave, NGW = G * 8;
    float* LB = (float*)(p.ws + OFF_LB);
    convert_set(lds, p, 0, gw, NGW, lane, wave);
    const int gt = bid * 512 + tid, NT = G * 512;
    for (int i = gt; i < 4 * MP; i += NT) ((float*)(p.ws + OFF_SS))[MP + i] = 0.f;
    for (int i = gt; i < 2 * 2048; i += NT) { const int cc = i & 2047; LB[i] = i < 2048 ? 0.f : 1.f / (1.f + __expf(p.in[8][cc] - p.in[8][2048 + cc])); }
}

__global__ void __launch_bounds__(512) yoco_fwd(Params p) {
    extern __shared__ __attribute__((aligned(16))) unsigned char lds_raw[];
    LAS unsigned char* lds = (LAS unsigned char*)lds_raw;
    cg::grid_group grid = cg::this_grid();
    if (threadIdx.x == 0) { ((volatile LAS unsigned*)(lds + LDS_ST))[0] = 0u; ((volatile LAS unsigned*)(lds + LDS_ST))[1] = 0u; }
    __syncthreads();
    const XcdBarrier xbar = xcd_barrier_post((unsigned*)(p.ws + OFF_CTL), (volatile LAS unsigned*)(lds + LDS_ST));
    constexpr int NPH = 18;
#pragma unroll 1
    for (int ph = 0; ph < NPH; ++ph) {
        int kind, arg;
        switch (ph) {
            case 0: kind = 0; arg = 0; break;
            case 1: kind = 2; arg = 0; break;   case 2: kind = 3; arg = 0; break;   case 3: kind = 4; arg = 0; break;   case 4: kind = 7; arg = 0; break;
            case 5: kind = 2; arg = 1; break;   case 6: kind = 3; arg = 1; break;   case 7: kind = 4; arg = 1; break;   case 8: kind = 7; arg = 1; break;
            case 9: kind = 5; arg = 0; break;   case 10: kind = 6; arg = 0; break;  case 11: kind = 4; arg = 2; break;  case 12: kind = 7; arg = 2; break;
            case 13: kind = 5; arg = 1; break;  case 14: kind = 6; arg = 1; break;  case 15: kind = 4; arg = 3; break;  case 16: kind = 7; arg = 3; break;
            default: kind = 1; arg = 1; break;
        }
        asm volatile("" : "+s"(kind), "+s"(arg));
        unsigned char* ws = p.ws;
        const int G = gridDim.x, bid = blockIdx.x;
        if (kind == 0) { prologue_phase(lds, p); norm_phase(p, 2); }
        else if (kind == 1) norm_phase(p, arg);
        else if (kind == 2) {
            const int l = arg;
            GSched S; S.X = (const char*)(ws + OFF_XB); S.W = (const char*)(ws + OFF_WIN_A) + (size_t)l * 12288 * D * 2; S.K = D; S.nM = 34; S.nN = 48; S.pn0 = 0; S.t0 = 32; S.t1 = 48; S.G = G; S.c = bid; S.split = 0;
            EpiHgrnIn E{(bf16_t*)(ws + OFF_Q), (bf16_t*)(ws + OFF_K), (float*)(ws + OFF_LF), (bf16_t*)(ws + OFF_VT), (bf16_t*)(ws + OFF_G), (const float*)(ws + OFF_LB) + l * 2048, (const float*)(ws + OFF_SS) + (size_t)l * MP, p.in[9] + l * 256};
            gemm_phase(lds, S, E);
        } else if (kind == 3) {
            scan_phase(lds, p, arg, true, (const bf16_t*)(ws + OFF_Q), (const bf16_t*)(ws + OFF_K), (const float*)(ws + OFF_LF), (const bf16_t*)(ws + OFF_VT), (const bf16_t*)(ws + OFF_G), (bf16_t*)(ws + OFF_OG));
        } else if (kind == 4) {
            GSched S; S.X = (const char*)(ws + OFF_OG); S.W = (const char*)(ws + (arg < 2 ? OFF_WOUT_A : OFF_WOUT_B)) + (size_t)(arg & 1) * D * EW * 2; S.K = EW; S.nM = 34; S.nN = 8; S.pn0 = 0; S.t0 = 0; S.t1 = 0; S.G = G; S.c = bid; S.split = 1;
            EpiOut E{(float*)(ws + OFF_X), (bf16_t*)(ws + OFF_XB), (float*)(ws + OFF_SS) + (size_t)(arg + 1) * MP, (float*)(ws + OFF_Q)};
            gemm_phase(lds, S, E);
        } else if (kind == 5) {
            const int l = arg;
            GSched S; S.X = (const char*)(ws + OFF_XB); S.W = (const char*)(ws + OFF_WKV) + (size_t)l * 8192 * D * 2; S.K = D; S.nM = 34; S.nN = l == 0 ? 36 : 32; S.pn0 = l == 0 ? 0 : 4; S.t0 = 2; S.t1 = 4; S.G = G; S.c = bid; S.split = 0;
            EpiSwaIn E{(bf16_t*)(ws + OFF_KS), (bf16_t*)(ws + OFF_VTS), (bf16_t*)(ws + OFF_Q), (bf16_t*)(ws + OFF_G), (const float*)(ws + OFF_SS) + (size_t)(2 + l) * MP};
            gemm_phase(lds, S, E);
        } else if (kind == 7) {
            reduce_phase(p, arg + 1);
        } else if (kind == 6) {
            attn_phase(lds, p, arg, (const bf16_t*)(ws + OFF_Q), (const bf16_t*)(ws + OFF_KS), (const bf16_t*)(ws + OFF_VTS), (const bf16_t*)(ws + OFF_G), (bf16_t*)(ws + OFF_OG));
        }
        if (ph + 1 < NPH) { if (gridDim.x == 0x7fffffffu) grid.sync(); else xcd_barrier(xbar); }
    }
}

extern "C" void kernel_launch(void* const* d_in, const int* in_sizes, int n_in, void* d_out, int out_size, void* d_ws, size_t ws_size, hipStream_t stream) {
    static int grid_blocks = 0;
    if (grid_blocks == 0) {
        if (n_in != 18 || ws_size < WS_END) { fprintf(stderr, "kernel_launch: unexpected n_in %d / ws_size %zu (need %zu)\n", n_in, ws_size, (size_t)WS_END); grid_blocks = -1; return; }
        int dev = 0, cus = 0, per_cu = 0;
        hipGetDevice(&dev);
        hipDeviceGetAttribute(&cus, hipDeviceAttributeMultiprocessorCount, dev);
        hipFuncSetAttribute((const void*)yoco_fwd, hipFuncAttributeMaxDynamicSharedMemorySize, LDS_BYTES);
        hipOccupancyMaxActiveBlocksPerMultiprocessor(&per_cu, (const void*)yoco_fwd, 512, LDS_BYTES);
        if (per_cu < 1) { fprintf(stderr, "kernel_launch: occupancy query returned %d\n", per_cu); per_cu = 1; }
        grid_blocks = cus * 1;
    }
    if (grid_blocks < 0) return;
    if (hipMemsetAsync((char*)d_ws + OFF_CTL, 0, CTL_BYTES, stream) != hipSuccess) { fprintf(stderr, "kernel_launch: memset of the barrier words failed\n"); return; }
    Params p{};
    for (int i = 0; i < 18; ++i) p.in[i] = (const float*)d_in[i];
    p.out = (float*)d_out; p.ws = (unsigned char*)d_ws;
    void* args[] = {&p};
    hipError_t e = hipLaunchCooperativeKernel((const void*)yoco_fwd, dim3(grid_blocks), dim3(512), args, LDS_BYTES, stream);
    if (e != hipSuccess) fprintf(stderr, "cooperative launch failed: %s (grid %d)\n", hipGetErrorString(e), grid_blocks);
}
```
